# Optimizing an MI355X kernel written in HIP

```python
import math
import jax, jax.numpy as jnp
from jax import lax
import numpy as np

D_MODEL = 1024
BATCH = 2
SEQ = 8192
DEPTH = 1

PLE_DIM = 256
EPS = 1e-6

GLA_HEADS = 4
GLA_DK = 64
GLA_DV = 128
GLA_RANK = 16
GLA_TAU = 16.0
GLA_CHUNK = 64
GLA_WIDTH = GLA_HEADS * GLA_DV

NSA_HEADS = 8
NSA_KV_HEADS = 2
NSA_GROUP = NSA_HEADS // NSA_KV_HEADS
NSA_DH = 64
NSA_WIDTH = NSA_HEADS * NSA_DH
NSA_KVW = NSA_KV_HEADS * NSA_DH
CMP_LEN = 32
CMP_STRIDE = 16
CMP_HIDDEN = 2 * NSA_DH
SLC_BLOCK = 64
SLC_TOPN = 16
WINDOW = 512
Q_BLOCK = 128
N_BRANCH = 3

ROPE_THETA = 500000.0
ROPE_DIM = NSA_DH // 4

MIX_WIDTH = GLA_WIDTH + NSA_WIDTH
SPLIT_SIZES = [
    GLA_HEADS * GLA_DK,
    GLA_HEADS * GLA_DK,
    GLA_WIDTH,
    GLA_RANK,
    GLA_WIDTH,
    NSA_WIDTH,
    NSA_KVW, NSA_KVW,
    NSA_KVW, NSA_KVW,
    NSA_KVW, NSA_KVW,
    NSA_HEADS * N_BRANCH,
    NSA_WIDTH,
]
IN_WIDTH = int(sum(SPLIT_SIZES))
SPLIT_POINTS = [int(v) for v in np.cumsum(SPLIT_SIZES)[:-1]]

kernel_name = "hymba_gla_nsa_sandwich_ple"


def rms_norm(x, gain):
    xf = x.astype(jnp.float32)
    y = xf * lax.rsqrt(jnp.mean(xf * xf, axis=-1, keepdims=True) + EPS)
    return (y * gain.astype(jnp.float32)).astype(x.dtype)


def rope_partial(x, pos):
    half = ROPE_DIM // 2
    inv = ROPE_THETA ** (-(jnp.arange(half, dtype=jnp.float32) * 2.0) / ROPE_DIM)
    ang = pos.astype(jnp.float32)[:, None] * inv[None, :]
    cos = jnp.cos(ang)[:, None, :]
    sin = jnp.sin(ang)[:, None, :]
    xr = x[..., :ROPE_DIM].astype(jnp.float32)
    x1, x2 = xr[..., :half], xr[..., half:]
    rot = jnp.concatenate([x1 * cos - x2 * sin, x2 * cos + x1 * sin], axis=-1)
    return jnp.concatenate([rot.astype(x.dtype), x[..., ROPE_DIM:]], axis=-1)


def gla_mixer(q, k, v, log_a):
    B, T = q.shape[0], q.shape[1]
    n = T // GLA_CHUNK

    def to_chunks(t):
        return t.astype(jnp.float32).reshape(B, n, GLA_CHUNK, *t.shape[2:]).swapaxes(0, 1)

    qc, kc, vc, gc = (to_chunks(t) for t in (q * (GLA_DK ** -0.5), k, v, log_a))
    causal = jnp.tril(jnp.ones((GLA_CHUNK, GLA_CHUNK), dtype=bool))[None, :, :, None, None]

    def step(S, inp):
        q_, k_, v_, g_ = inp
        b = jnp.cumsum(g_, axis=1)
        o_inter = jnp.einsum('bchk,bhkv->bchv', q_ * jnp.exp(b), S)
        diff = b[:, :, None] - b[:, None, :]
        decay = jnp.exp(jnp.where(causal, diff, -jnp.inf))
        att = jnp.einsum('bihk,bjhk,bijhk->bhij', q_, k_, decay)
        o_intra = jnp.einsum('bhij,bjhv->bihv', att, v_)
        b_last = b[:, -1]
        S = jnp.exp(b_last)[..., None] * S + jnp.einsum(
            'bjhk,bjhv->bhkv', k_ * jnp.exp(b_last[:, None] - b), v_)
        return S, o_inter + o_intra

    S0 = jnp.zeros((B, GLA_HEADS, GLA_DK, GLA_DV), jnp.float32)
    _, o = lax.scan(step, S0, (qc, kc, vc, gc))
    return o.swapaxes(0, 1).reshape(B, T, GLA_HEADS, GLA_DV)


def _take_blocks(kb, ix):
    return kb[ix]


_gather_blocks = jax.vmap(jax.vmap(_take_blocks))


def nsa_mixer(q, k_cmp, v_cmp, k_slc, v_slc, k_win, v_win, gates,
              cmp_pos_k, cmp_w1_k, cmp_w2_k, cmp_pos_v, cmp_w1_v, cmp_w2_v):
    B, T = q.shape[0], q.shape[1]
    f32 = jnp.float32
    pos = jnp.arange(T)
    q = rope_partial(q, pos) * (NSA_DH ** -0.5)
    k_slc = rope_partial(k_slc, pos)
    k_win = rope_partial(k_win, pos)

    n_cmp = (T - CMP_LEN) // CMP_STRIDE + 1
    blk_idx = np.arange(n_cmp)[:, None] * CMP_STRIDE + np.arange(CMP_LEN)[None, :]

    def compress(t, pos_emb, w1, w2):
        blocks = t[:, blk_idx] + pos_emb[None, None, :, None, :]
        flat = blocks.transpose(0, 1, 3, 2, 4).reshape(B, n_cmp, NSA_KV_HEADS, CMP_LEN * NSA_DH)
        return jax.nn.silu(flat @ w1) @ w2

    cmp_end_np = np.arange(n_cmp) * CMP_STRIDE + CMP_LEN - 1
    cmp_end = jnp.asarray(cmp_end_np)
    kc = rope_partial(compress(k_cmp, cmp_pos_k, cmp_w1_k, cmp_w2_k), cmp_end).astype(f32)
    vc = compress(v_cmp, cmp_pos_v, cmp_w1_v, cmp_w2_v).astype(f32)

    n_slc = T // SLC_BLOCK
    n_sel = min(SLC_TOPN, n_slc)
    cs = np.arange(n_cmp) * CMP_STRIDE
    ss = np.arange(n_slc) * SLC_BLOCK
    cmp_to_slc = jnp.asarray(((cs[:, None] < ss[None, :] + SLC_BLOCK) &
                              (cs[:, None] + CMP_LEN > ss[None, :])).astype(np.float32))
    ks_blk = k_slc.reshape(B, n_slc, SLC_BLOCK, NSA_KV_HEADS, NSA_DH).transpose(0, 3, 1, 2, 4)
    vs_blk = v_slc.reshape(B, n_slc, SLC_BLOCK, NSA_KV_HEADS, NSA_DH).transpose(0, 3, 1, 2, 4)

    kw_pad = jnp.pad(k_win, ((0, 0), (WINDOW, 0), (0, 0), (0, 0)))
    vw_pad = jnp.pad(v_win, ((0, 0), (WINDOW, 0), (0, 0), (0, 0)))
    slc_ids = jnp.arange(n_slc)

    def block(qb):
        q0 = qb * Q_BLOCK
        t = q0 + jnp.arange(Q_BLOCK)
        qblk = lax.dynamic_slice_in_dim(q, q0, Q_BLOCK, 1).astype(f32).reshape(
            B, Q_BLOCK, NSA_KV_HEADS, NSA_GROUP, NSA_DH)

        s = jnp.einsum('bqhgd,bihd->bhgqi', qblk, kc)
        valid = cmp_end[None, :] <= t[:, None]
        p_cmp = jax.nn.softmax(jnp.where(valid, s, -1e30), axis=-1) * valid
        o_cmp = jnp.einsum('bhgqi,bihd->bqhgd', p_cmp, vc)

        imp = jnp.einsum('bhgqi,ij->bhqj', p_cmp, cmp_to_slc)
        cur = t // SLC_BLOCK
        forced = (slc_ids[None, :] == 0) | (slc_ids[None, :] == cur[:, None]) | \
                 (slc_ids[None, :] == cur[:, None] - 1)
        imp = jnp.where(forced, 1e3, jnp.where(slc_ids[None, :] <= cur[:, None], imp, -1.0))
        _, sel = lax.top_k(imp, n_sel)
        k_g = _gather_blocks(ks_blk, sel).astype(f32)
        v_g = _gather_blocks(vs_blk, sel).astype(f32)
        s = jnp.einsum('bqhgd,bhqnld->bhgqnl', qblk, k_g)
        kpos = sel[..., None] * SLC_BLOCK + jnp.arange(SLC_BLOCK)
        m = (kpos <= t[None, None, :, None, None])[:, :, None]
        s = jnp.where(m, s, -1e30)
        p_slc = jax.nn.softmax(s.reshape(*s.shape[:4], n_sel * SLC_BLOCK), axis=-1).reshape(s.shape)
        o_slc = jnp.einsum('bhgqnl,bhqnld->bqhgd', p_slc, v_g)

        kw = lax.dynamic_slice_in_dim(kw_pad, q0, WINDOW + Q_BLOCK, 1).astype(f32)
        vw = lax.dynamic_slice_in_dim(vw_pad, q0, WINDOW + Q_BLOCK, 1).astype(f32)
        kpos_w = q0 - WINDOW + jnp.arange(WINDOW + Q_BLOCK)
        dist = t[:, None] - kpos_w[None, :]
        mw = (kpos_w[None, :] >= 0) & (dist >= 0) & (dist < WINDOW)
        s = jnp.einsum('bqhgd,bkhd->bhgqk', qblk, kw)
        p_win = jax.nn.softmax(jnp.where(mw, s, -1e30), axis=-1)
        o_win = jnp.einsum('bhgqk,bkhd->bqhgd', p_win, vw)

        g = lax.dynamic_slice_in_dim(gates, q0, Q_BLOCK, 1).astype(f32).reshape(
            B, Q_BLOCK, NSA_KV_HEADS, NSA_GROUP, N_BRANCH)
        o = g[..., 0:1] * o_cmp + g[..., 1:2] * o_slc + g[..., 2:3] * o_win
        return o.reshape(B, Q_BLOCK, NSA_WIDTH)

    out = lax.map(block, jnp.arange(T // Q_BLOCK))
    return out.transpose(1, 0, 2, 3).reshape(B, T, NSA_WIDTH)


def setup_inputs(seed: int = 0) -> dict:
    key = jax.random.key(seed)
    ks = jax.random.split(key, 24)
    f32 = jnp.float32

    def nrm(k, shape, scale):
        return jax.random.normal(k, shape, f32) * scale

    def gain(k, shape):
        return 1.0 + 0.01 * jax.random.normal(k, shape, f32)

    L = DEPTH
    return {
        "x": nrm(ks[0], (BATCH, SEQ, D_MODEL), 1.0),
        "p": nrm(ks[1], (DEPTH, BATCH, SEQ, PLE_DIM), 1.0),
        "pre_norm": gain(ks[2], (L, D_MODEL)),
        "w_in": nrm(ks[3], (L, D_MODEL, IN_WIDTH), D_MODEL ** -0.5),
        "gla_a_up": nrm(ks[4], (L, GLA_RANK, GLA_HEADS * GLA_DK), GLA_RANK ** -0.5),
        "gla_a_bias": nrm(ks[5], (L, GLA_HEADS * GLA_DK), 0.1),
        "gla_out_norm": gain(ks[6], (L, GLA_DV)),
        "cmp_pos_k": nrm(ks[7], (L, CMP_LEN, NSA_DH), 0.02),
        "cmp_w1_k": nrm(ks[8], (L, CMP_LEN * NSA_DH, CMP_HIDDEN), (CMP_LEN * NSA_DH) ** -0.5),
        "cmp_w2_k": nrm(ks[9], (L, CMP_HIDDEN, NSA_DH), CMP_HIDDEN ** -0.5),
        "cmp_pos_v": nrm(ks[10], (L, CMP_LEN, NSA_DH), 0.02),
        "cmp_w1_v": nrm(ks[11], (L, CMP_LEN * NSA_DH, CMP_HIDDEN), (CMP_LEN * NSA_DH) ** -0.5),
        "cmp_w2_v": nrm(ks[12], (L, CMP_HIDDEN, NSA_DH), CMP_HIDDEN ** -0.5),
        "w_out": nrm(ks[13], (L, MIX_WIDTH, D_MODEL), MIX_WIDTH ** -0.5),
        "post_norm": gain(ks[14], (L, D_MODEL)),
        "ple_proj": nrm(ks[15], (L, PLE_DIM, D_MODEL), PLE_DIM ** -0.5),
        "ple_gate": nrm(ks[16], (L, D_MODEL, D_MODEL), D_MODEL ** -0.5),
        "ple_norm": gain(ks[17], (L, D_MODEL)),
    }


def reference(x, p, pre_norm, w_in, gla_a_up, gla_a_bias, gla_out_norm,
              cmp_pos_k, cmp_w1_k, cmp_w2_k, cmp_pos_v, cmp_w1_v, cmp_w2_v,
              w_out, post_norm, ple_proj, ple_gate, ple_norm):
    B, T, _ = x.shape
    h = x
    for i in range(DEPTH):
        xn = rms_norm(h, pre_norm[i])
        proj = xn @ w_in[i]
        (g_q, g_k, g_v, g_a, g_z, n_q, n_kc, n_vc, n_ks, n_vs, n_kw, n_vw, n_g, n_z) = \
            jnp.split(proj, SPLIT_POINTS, axis=-1)

        log_a = jax.nn.log_sigmoid((g_a @ gla_a_up[i] + gla_a_bias[i]).astype(jnp.float32)) / GLA_TAU
        o_gla = gla_mixer(g_q.reshape(B, T, GLA_HEADS, GLA_DK),
                          g_k.reshape(B, T, GLA_HEADS, GLA_DK),
                          g_v.reshape(B, T, GLA_HEADS, GLA_DV),
                          log_a.reshape(B, T, GLA_HEADS, GLA_DK))
        o_gla = rms_norm(o_gla, gla_out_norm[i]).reshape(B, T, GLA_WIDTH)
        o_gla = (o_gla * jax.nn.silu(g_z.astype(jnp.float32))).astype(x.dtype)

        kv = lambda t: t.reshape(B, T, NSA_KV_HEADS, NSA_DH)
        gates = jax.nn.sigmoid(n_g.astype(jnp.float32)).reshape(B, T, NSA_HEADS, N_BRANCH)
        o_nsa = nsa_mixer(n_q.reshape(B, T, NSA_HEADS, NSA_DH), kv(n_kc), kv(n_vc), kv(n_ks), kv(n_vs),
                          kv(n_kw), kv(n_vw), gates,
                          cmp_pos_k[i], cmp_w1_k[i], cmp_w2_k[i], cmp_pos_v[i], cmp_w1_v[i], cmp_w2_v[i])
        o_nsa = (o_nsa * jax.nn.silu(n_z.astype(jnp.float32))).astype(x.dtype)

        mixed = jnp.concatenate([o_gla, o_nsa], axis=-1) @ w_out[i]
        h = h + rms_norm(mixed, post_norm[i])

        gate = jax.nn.sigmoid((h @ ple_gate[i]).astype(jnp.float32))
        e = (p[i] @ ple_proj[i]).astype(jnp.float32) * gate
        h = h + rms_norm(e.astype(x.dtype), ple_norm[i])
    return h
```

```cpp
#include <hip/hip_runtime.h>
#include <hip/hip_bf16.h>
#include <hip/hip_cooperative_groups.h>
#include <cstdio>
namespace cg = cooperative_groups;

#ifndef FUSED
#define FUSED 1
#endif

typedef unsigned short u16;
using bf16x8 = __attribute__((ext_vector_type(8))) short;
using f32x4 = __attribute__((ext_vector_type(4))) float;
using f32x16 = __attribute__((ext_vector_type(16))) float;
typedef __bf16 bf2_t __attribute__((ext_vector_type(2)));
typedef float f2_t __attribute__((ext_vector_type(2)));

#define NTHR 512
#define SEQ 8192
#define MTOK 16384
#define PP 3368
#define C_GQ 0
#define C_GK 256
#define C_GV 512
#define C_GA 1024
#define C_GZ 1040
#define C_NQ 1552
#define C_KC 2064
#define C_VC 2192
#define C_KS 2320
#define C_VS 2448
#define C_KW 2576
#define C_VW 2704
#define C_NG 2832
#define C_NZ 2856
#define EPSV 1e-6f
#define QSCALE_L2 0.18033688011112042f

constexpr size_t WS_XN = 0;
constexpr size_t WS_WTIN = WS_XN + (size_t)MTOK * 1024 * 2;
constexpr size_t WS_WTOUT = WS_WTIN + (size_t)3584 * 1024 * 2;
constexpr size_t WS_WTG = WS_WTOUT + (size_t)1024 * 1024 * 2;
constexpr size_t WS_WTP = WS_WTG + (size_t)1024 * 1024 * 2;
constexpr size_t WS_W1K = WS_WTP + (size_t)1024 * 256 * 2;
constexpr size_t WS_W1V = WS_W1K + (size_t)128 * 2048 * 2;
constexpr size_t WS_W2K = WS_W1V + (size_t)128 * 2048 * 2;
constexpr size_t WS_W2V = WS_W2K + (size_t)64 * 128 * 2;
constexpr size_t WS_PB = WS_W2V + (size_t)64 * 128 * 2;
constexpr size_t WS_ROPEC = WS_PB + (size_t)MTOK * 256 * 2;
constexpr size_t WS_ROPES = WS_ROPEC + (size_t)SEQ * 8 * 4;
constexpr size_t WS_SS1 = WS_ROPES + (size_t)SEQ * 8 * 4;
constexpr size_t WS_SS2 = WS_SS1 + (size_t)MTOK * 4;
constexpr size_t WS_PROJ = WS_SS2 + (size_t)MTOK * 4;
constexpr size_t WS_BCUM = WS_PROJ + (size_t)MTOK * PP * 2;
constexpr size_t WS_DS = WS_BCUM + (size_t)MTOK * 256 * 4;
constexpr size_t WS_DEC = WS_DS + (size_t)1024 * 8192 * 4;
constexpr size_t WS_KC = WS_DEC + (size_t)1024 * 64 * 4;
constexpr size_t WS_VCT = WS_KC + (size_t)4 * 512 * 64 * 2;
constexpr size_t WS_VST = WS_VCT + (size_t)4 * 512 * 64 * 2;
constexpr size_t WS_VWT = WS_VST + (size_t)4 * 64 * SEQ * 2;
constexpr size_t WS_BAR = WS_VWT + (size_t)4 * 64 * SEQ * 2;
constexpr size_t WS_END = WS_BAR + 16384;
constexpr size_t WS_E1 = WS_END;
constexpr size_t WS_END2 = WS_E1 + (size_t)MTOK * 1024 * 2;

struct Params {
  const float *x, *p, *pre_norm, *w_in, *a_up, *a_bias, *gnorm, *pos_k, *w1k, *w2k, *pos_v, *w1v, *w2v, *w_out, *post_norm,
      *ple_proj, *ple_gate, *ple_norm;
  float* out;
  unsigned char* ws;
};

extern __shared__ __attribute__((aligned(16))) unsigned char smem[];

__device__ __forceinline__ float bf2f(u16 h) { return __uint_as_float(((unsigned)h) << 16); }
__device__ __forceinline__ unsigned pk2(float a, float b) {
  f2_t v = {a, b};
  bf2_t r = __builtin_convertvector(v, bf2_t);
  return *(unsigned*)&r;
}
__device__ __forceinline__ u16 f2bf(float a) { return (u16)(pk2(a, 0.f) & 0xFFFFu); }
__device__ __forceinline__ float wave_sum(float v) {
  for (int o = 32; o > 0; o >>= 1) v += __shfl_xor(v, o);
  return v;
}
__device__ __forceinline__ float sigmoidf_(float x) { return __builtin_amdgcn_rcpf(1.f + __expf(-x)); }
__device__ __forceinline__ float siluf_(float x) { return x * __builtin_amdgcn_rcpf(1.f + __expf(-x)); }
__device__ __forceinline__ float ex2(float x) { return __builtin_amdgcn_exp2f(x); }
__device__ __forceinline__ float quad_sum(float v) {
  v += __int_as_float(__builtin_amdgcn_mov_dpp(__float_as_int(v), 0xB1, 0xF, 0xF, true));
  v += __int_as_float(__builtin_amdgcn_mov_dpp(__float_as_int(v), 0x4E, 0xF, 0xF, true));
  return v;
}
__device__ __forceinline__ f32x16 mfma32(bf16x8 a, bf16x8 b, f32x16 c) {
  return __builtin_amdgcn_mfma_f32_32x32x16_bf16(a, b, c, 0, 0, 0);
}
union U8 {
  bf16x8 v;
  uint4 u;
  uint2 h[2];
  u16 s[8];
};

constexpr int G_BK = 64, G_HALF = 128, G_HT = G_HALF * G_BK;
__device__ __forceinline__ int lds_byte(int r, int c) {
  int st = (r >> 4) * 2 + (c >> 5), rr = r & 15, cc = c & 31, ob = rr * 64 + cc * 2;
  return st * 1024 + (ob ^ (((ob >> 9) & 1) << 5));
}
__device__ __forceinline__ void stage_rc(int b, int& R, int& C) {
  int st = b / 1024, sb = b % 1024, swz = sb ^ (((sb >> 9) & 1) << 5);
  R = (st >> 1) * 16 + swz / 64;
  C = (st & 1) * 32 + (swz % 64) / 2;
}

template <int K, bool SWAP = false>
__device__ __forceinline__ void gemm256(const u16* __restrict__ A, const u16* __restrict__ Bt, const int brow,
                                        const int bcol, f32x4 (&acc)[2][2][4][2]) {
  u16* shm = (u16*)smem;
#define SA(b, h) (shm + ((b)*2 + (h)) * G_HT)
#define SB(b, h) (shm + (4 + (b)*2 + (h)) * G_HT)
#define STAGE(P, BASE, br, kt)                                                                                       \
  do {                                                                                                               \
    long _g = (long)(br)*K + (long)(kt)*G_BK;                                                                        \
    for (int _i = 0; _i < 2; ++_i) {                                                                                 \
      int _b = tidx * 16 + _i * 8192;                                                                                \
      int _r, _c;                                                                                                    \
      stage_rc(_b, _r, _c);                                                                                          \
      __builtin_amdgcn_global_load_lds((const unsigned*)(BASE + _g + (long)_r * K + _c), (unsigned*)((char*)(P) + _b), \
                                       16, 0, 0);                                                                    \
    }                                                                                                                \
  } while (0)
#define LDA(dst, b, h)                                                                                               \
  for (int m = 0; m < 4; ++m)                                                                                        \
    for (int k = 0; k < 2; ++k)                                                                                      \
  dst[m][k] = *reinterpret_cast<const bf16x8*>((char*)SA(b, h) + lds_byte(wr * 64 + m * 16 + fr, k * 32 + fq * 8))
#define LDB(dst, b, h)                                                                                               \
  for (int n = 0; n < 2; ++n)                                                                                        \
    for (int k = 0; k < 2; ++k)                                                                                      \
  dst[n][k] = *reinterpret_cast<const bf16x8*>((char*)SB(b, h) + lds_byte(wc * 32 + n * 16 + fr, k * 32 + fq * 8))
#define MMA(ai, bj, At, Bt_)                                                                                         \
  do {                                                                                                               \
    __builtin_amdgcn_s_setprio(1);                                                                                   \
    for (int m = 0; m < 4; ++m)                                                                                      \
      for (int n = 0; n < 2; ++n)                                                                                    \
        for (int k = 0; k < 2; ++k)                                                                                  \
          acc[ai][bj][m][n] = SWAP ? __builtin_amdgcn_mfma_f32_16x16x32_bf16(Bt_[n][k], At[m][k], acc[ai][bj][m][n], 0, 0, 0) \
                                   : __builtin_amdgcn_mfma_f32_16x16x32_bf16(At[m][k], Bt_[n][k], acc[ai][bj][m][n], 0, 0, 0); \
    __builtin_amdgcn_s_setprio(0);                                                                                   \
  } while (0)
#define WAIT_V(n) asm volatile("s_waitcnt vmcnt(" #n ")" ::: "memory")
#define WAIT_L(n) asm volatile("s_waitcnt lgkmcnt(" #n ")" ::: "memory")
#define BAR __builtin_amdgcn_s_barrier()
#define SCHED __builtin_amdgcn_sched_barrier(0)
  int tidx = threadIdx.x;
  asm volatile("" : "+v"(tidx));
  const int wid = tidx >> 6, lane = tidx & 63, wr = wid >> 2, wc = wid & 3, fr = lane & 15, fq = lane >> 4;
#pragma unroll
  for (int a = 0; a < 2; ++a)
#pragma unroll
    for (int b = 0; b < 2; ++b)
#pragma unroll
      for (int m = 0; m < 4; ++m)
#pragma unroll
        for (int n = 0; n < 2; ++n) acc[a][b][m][n] = f32x4{0.f, 0.f, 0.f, 0.f};
  bf16x8 At[4][2], B0[2][2], B1[2][2];
  const int nt = K / G_BK;
  STAGE(SB(0, 0), Bt, bcol, 0);
  STAGE(SA(0, 0), A, brow, 0);
  STAGE(SB(0, 1), Bt, bcol + G_HALF, 0);
  STAGE(SA(0, 1), A, brow + G_HALF, 0);
  if (wr == 1) BAR;
  WAIT_V(4);
  BAR;
  STAGE(SB(1, 0), Bt, bcol, 1);
  STAGE(SA(1, 0), A, brow, 1);
  STAGE(SB(1, 1), Bt, bcol + G_HALF, 1);
  WAIT_V(6);
  BAR;
  for (int t = 0; t < nt - 2; t += 2) {
    LDB(B0, 0, 0); SCHED; LDA(At, 0, 0); STAGE(SA(1, 1), A, brow + G_HALF, t + 1);
    WAIT_L(8); BAR; WAIT_L(0); MMA(0, 0, At, B0); BAR; SCHED;
    LDB(B1, 0, 1); STAGE(SB(0, 0), Bt, bcol, t + 2);
    BAR; WAIT_L(0); MMA(0, 1, At, B1); BAR;
    LDA(At, 0, 1); STAGE(SA(0, 0), A, brow, t + 2);
    BAR; WAIT_L(0); MMA(1, 0, At, B0); BAR; SCHED;
    STAGE(SB(0, 1), Bt, bcol + G_HALF, t + 2);
    WAIT_V(6); BAR; MMA(1, 1, At, B1); BAR;
    LDB(B0, 1, 0); SCHED; LDA(At, 1, 0); STAGE(SA(0, 1), A, brow + G_HALF, t + 2);
    WAIT_L(8); BAR; WAIT_L(0); MMA(0, 0, At, B0); BAR; SCHED;
    LDB(B1, 1, 1); STAGE(SB(1, 0), Bt, bcol, t + 3);
    BAR; WAIT_L(0); MMA(0, 1, At, B1); BAR;
    LDA(At, 1, 1); STAGE(SA(1, 0), A, brow, t + 3);
    BAR; WAIT_L(0); MMA(1, 0, At, B0); BAR; SCHED;
    STAGE(SB(1, 1), Bt, bcol + G_HALF, t + 3);
    WAIT_V(6); BAR; MMA(1, 1, At, B1); BAR;
  }
  {
    LDB(B0, 0, 0); LDA(At, 0, 0); STAGE(SA(1, 1), A, brow + G_HALF, nt - 1);
    BAR; WAIT_L(0); MMA(0, 0, At, B0); BAR;
    LDB(B1, 0, 1); BAR; WAIT_L(0); MMA(0, 1, At, B1); BAR;
    LDA(At, 0, 1); WAIT_V(4); BAR; WAIT_L(0); MMA(1, 0, At, B0); MMA(1, 1, At, B1); BAR;
  }
  {
    LDB(B0, 1, 0); LDA(At, 1, 0); WAIT_V(2); BAR; WAIT_L(0); MMA(0, 0, At, B0); BAR;
    LDB(B1, 1, 1); WAIT_V(0); BAR; WAIT_L(0); MMA(0, 1, At, B1); BAR;
    LDA(At, 1, 1); BAR; WAIT_L(0); MMA(1, 0, At, B0); MMA(1, 1, At, B1); BAR;
  }
  if (wr == 0) BAR;
#undef SA
#undef SB
#undef STAGE
#undef LDA
#undef LDB
#undef MMA
}

__device__ __forceinline__ void tile_map(int wgid, int nM, int nN, int& pm, int& pn) {
  const int NX = 8, WGM = 8;
  int nwg = nM * nN;
  {
    int q = nwg / NX, r = nwg % NX, xcd = wgid % NX, off = wgid / NX;
    wgid = (xcd < r ? xcd * (q + 1) : r * (q + 1) + (xcd - r) * q) + off;
  }
  int nig = WGM * nN, gid = wgid / nig, fm = gid * WGM, gsz = min(nM - fm, WGM);
  pm = fm + ((wgid % nig) % gsz);
  pn = (wgid % nig) / gsz;
}

__device__ __forceinline__ void e1_tile(unsigned char* ws, int t2, f32x4 (&acc)[2][2][4][2]) {
  int pm, pn;
  tile_map(t2, 64, 4, pm, pn);
  const int brow = pm * 256, bcol = pn * 256;
  gemm256<256, true>((const u16*)(ws + WS_PB), (const u16*)(ws + WS_WTP), brow, bcol, acc);
  int tide = threadIdx.x;
  asm volatile("" : "+v"(tide));
  const int wid = tide >> 6, lane = tide & 63, wr = wid >> 2, wc = wid & 3, fr = lane & 15, fq = lane >> 4;
  u16* E1 = (u16*)(ws + WS_E1);
#pragma unroll
  for (int ai = 0; ai < 2; ++ai)
#pragma unroll
    for (int m = 0; m < 4; ++m) {
      const int row = brow + ai * 128 + wr * 64 + m * 16 + fr;
#pragma unroll
      for (int bj = 0; bj < 2; ++bj)
#pragma unroll
        for (int n = 0; n < 2; ++n) {
          const int col0 = bcol + bj * 128 + wc * 32 + n * 16 + fq * 4;
          uint2 o;
          o.x = pk2(acc[ai][bj][m][n][0], acc[ai][bj][m][n][1]);
          o.y = pk2(acc[ai][bj][m][n][2], acc[ai][bj][m][n][3]);
          *(uint2*)(E1 + (size_t)row * 1024 + col0) = o;
        }
    }
  asm volatile("s_waitcnt vmcnt(0)" ::: "memory");
  __syncthreads();
}

template <int EPI>
__device__ __forceinline__ void gemm_phase(const Params& p) {
  unsigned char* ws = p.ws;
  const int nM = 64, nN = (EPI == 0) ? 14 : 4;
  f32x4 acc[2][2][4][2];
  for (int t = blockIdx.x; t < nM * nN; t += gridDim.x) {
    int tide = threadIdx.x;
    asm volatile("" : "+v"(tide));
    const int wid = tide >> 6, lane = tide & 63, wr = wid >> 2, wc = wid & 3, fr = lane & 15, fq = lane >> 4;
    int pm, pn;
    tile_map(t, nM, nN, pm, pn);
    const int brow = pm * 256, bcol = pn * 256;
    if (EPI == 0) {
      gemm256<1024>((const u16*)(ws + WS_XN), (const u16*)(ws + WS_WTIN), brow, bcol, acc);
      u16* PJ = (u16*)(ws + WS_PROJ);
#pragma unroll
      for (int ai = 0; ai < 2; ++ai)
#pragma unroll
        for (int bj = 0; bj < 2; ++bj)
#pragma unroll
          for (int m = 0; m < 4; ++m)
#pragma unroll
            for (int n = 0; n < 2; ++n) {
              int col = bcol + bj * 128 + wc * 32 + n * 16 + fr;
              if (col < PP) {
#pragma unroll
                for (int j = 0; j < 4; ++j) {
                  int row = brow + ai * 128 + wr * 64 + m * 16 + fq * 4 + j;
                  PJ[(size_t)row * PP + col] = f2bf(acc[ai][bj][m][n][j]);
                }
              }
            }
    } else if (EPI == 1) {
      gemm256<1024, true>((const u16*)(ws + WS_XN), (const u16*)(ws + WS_WTOUT), brow, bcol, acc);
      float* SS = (float*)(ws + WS_SS1);
#pragma unroll
      for (int ai = 0; ai < 2; ++ai)
#pragma unroll
        for (int m = 0; m < 4; ++m) {
          const int row = brow + ai * 128 + wr * 64 + m * 16 + fr;
          float ss = 0.f;
#pragma unroll
          for (int bj = 0; bj < 2; ++bj)
#pragma unroll
            for (int n = 0; n < 2; ++n)
#pragma unroll
              for (int j = 0; j < 4; ++j) ss += acc[ai][bj][m][n][j] * acc[ai][bj][m][n][j];
          ss += __shfl_xor(ss, 16);
          ss += __shfl_xor(ss, 32);
          if (fq == 0) atomicAdd(&SS[row], ss);
        }
      {
        unsigned* cnt = (unsigned*)(ws + WS_BAR) + 3584 + pm * 8 + 4;
        asm volatile("s_waitcnt vmcnt(0)" ::: "memory");
        __syncthreads();
        if (threadIdx.x == 0) {
          __builtin_amdgcn_fence(__ATOMIC_RELEASE, "agent");
          asm volatile("s_waitcnt vmcnt(0)" ::: "memory");
          __hip_atomic_fetch_add(cnt, 1u, __ATOMIC_RELAXED, __HIP_MEMORY_SCOPE_AGENT);
          unsigned sp = 0;
          while (__hip_atomic_load(cnt, __ATOMIC_RELAXED, __HIP_MEMORY_SCOPE_AGENT) < 4u) {
            __builtin_amdgcn_s_sleep(1);
            if (++sp > (1u << 22)) break;
          }
          __builtin_amdgcn_fence(__ATOMIC_ACQUIRE, "agent");
          asm volatile("s_waitcnt vmcnt(0)" ::: "memory");
        }
        __syncthreads();
        int tide4 = threadIdx.x;
        asm volatile("" : "+v"(tide4));
        const int wid4 = tide4 >> 6, lane4 = tide4 & 63, wr4 = wid4 >> 2, wc4 = wid4 & 3, fr4 = lane4 & 15, fq4 = lane4 >> 4;
        u16* HB = (u16*)(ws + WS_XN);
#pragma unroll
        for (int ai = 0; ai < 2; ++ai)
#pragma unroll
          for (int m = 0; m < 4; ++m) {
            const int row = brow + ai * 128 + wr4 * 64 + m * 16 + fr4;
            const float r1 = rsqrtf(__hip_atomic_load(&SS[row], __ATOMIC_RELAXED, __HIP_MEMORY_SCOPE_AGENT) * (1.f / 1024.f) + EPSV);
#pragma unroll
            for (int bj = 0; bj < 2; ++bj)
#pragma unroll
              for (int n = 0; n < 2; ++n) {
                const int col0 = bcol + bj * 128 + wc4 * 32 + n * 16 + fq4 * 4;
                const size_t idx = (size_t)row * 1024 + col0;
                const float4 xv = *(const float4*)(p.x + idx);
                const float4 gv = *(const float4*)(p.post_norm + col0);
                uint2 o;
                o.x = pk2(xv.x + acc[ai][bj][m][n][0] * r1 * gv.x, xv.y + acc[ai][bj][m][n][1] * r1 * gv.y);
                o.y = pk2(xv.z + acc[ai][bj][m][n][2] * r1 * gv.z, xv.w + acc[ai][bj][m][n][3] * r1 * gv.w);
                *(uint2*)(HB + idx) = o;
              }
            asm volatile("" ::: "memory");
          }
      }
    } else {
      const u16* E = (const u16*)(ws + WS_E1);
      float* SS = (float*)(ws + WS_SS2);
      gemm256<1024, true>((const u16*)(ws + WS_XN), (const u16*)(ws + WS_WTG), brow, bcol, acc);
      int tide2 = threadIdx.x;
      asm volatile("" : "+v"(tide2));
      const int wid2 = tide2 >> 6, lane2 = tide2 & 63, wr2 = wid2 >> 2, wc2 = wid2 & 3, fr2 = lane2 & 15, fq2 = lane2 >> 4;
#pragma unroll
      for (int ai = 0; ai < 2; ++ai)
#pragma unroll
        for (int m = 0; m < 4; ++m) {
          const int row = brow + ai * 128 + wr2 * 64 + m * 16 + fr2;
          float ss = 0.f;
#pragma unroll
          for (int bj = 0; bj < 2; ++bj)
#pragma unroll
            for (int n = 0; n < 2; ++n) {
              const int col0 = bcol + bj * 128 + wc2 * 32 + n * 16 + fq2 * 4;
              const uint2 eb = *(const uint2*)(E + (size_t)row * 1024 + col0);
              const float e0 = bf2f((u16)(eb.x & 0xFFFF)), e1 = bf2f((u16)(eb.x >> 16)), e2 = bf2f((u16)(eb.y & 0xFFFF)), e3 = bf2f((u16)(eb.y >> 16));
              const float v0 = e0 * sigmoidf_(acc[ai][bj][m][n][0]), v1 = e1 * sigmoidf_(acc[ai][bj][m][n][1]);
              const float v2 = e2 * sigmoidf_(acc[ai][bj][m][n][2]), v3 = e3 * sigmoidf_(acc[ai][bj][m][n][3]);
              acc[ai][bj][m][n][0] = v0; acc[ai][bj][m][n][1] = v1; acc[ai][bj][m][n][2] = v2; acc[ai][bj][m][n][3] = v3;
              ss += (v0 * v0 + v1 * v1) + (v2 * v2 + v3 * v3);
            }
          asm volatile("" ::: "memory");
          ss += __shfl_xor(ss, 16);
          ss += __shfl_xor(ss, 32);
          if (fq2 == 0) atomicAdd(&SS[row], ss);
        }
      {
        unsigned* cnt = (unsigned*)(ws + WS_BAR) + 3584 + pm * 8;
        asm volatile("s_waitcnt vmcnt(0)" ::: "memory");
        __syncthreads();
        if (threadIdx.x == 0) {
          __builtin_amdgcn_fence(__ATOMIC_RELEASE, "agent");
          asm volatile("s_waitcnt vmcnt(0)" ::: "memory");
          __hip_atomic_fetch_add(cnt, 1u, __ATOMIC_RELAXED, __HIP_MEMORY_SCOPE_AGENT);
          unsigned sp = 0;
          while (__hip_atomic_load(cnt, __ATOMIC_RELAXED, __HIP_MEMORY_SCOPE_AGENT) < 4u) {
            __builtin_amdgcn_s_sleep(1);
            if (++sp > (1u << 22)) break;
          }
          __builtin_amdgcn_fence(__ATOMIC_ACQUIRE, "agent");
          asm volatile("s_waitcnt vmcnt(0)" ::: "memory");
        }
        __syncthreads();
        int tide4 = threadIdx.x;
        asm volatile("" : "+v"(tide4));
        const int wid4 = tide4 >> 6, lane4 = tide4 & 63, wr4 = wid4 >> 2, wc4 = wid4 & 3, fr4 = lane4 & 15, fq4 = lane4 >> 4;
        const u16* HB = (const u16*)(ws + WS_XN);
#pragma unroll
        for (int ai = 0; ai < 2; ++ai)
#pragma unroll
          for (int m = 0; m < 4; ++m) {
            const int row = brow + ai * 128 + wr4 * 64 + m * 16 + fr4;
            const float r2 = rsqrtf(__hip_atomic_load(&SS[row], __ATOMIC_RELAXED, __HIP_MEMORY_SCOPE_AGENT) * (1.f / 1024.f) + EPSV);
#pragma unroll
            for (int bj = 0; bj < 2; ++bj)
#pragma unroll
              for (int n = 0; n < 2; ++n) {
                const int col0 = bcol + bj * 128 + wc4 * 32 + n * 16 + fq4 * 4;
                const size_t idx = (size_t)row * 1024 + col0;
                const uint2 hb = *(const uint2*)(HB + idx);
                const float4 gv = *(const float4*)(p.ple_norm + col0);
                float4 o;
                o.x = bf2f((u16)(hb.x & 0xFFFF)) + acc[ai][bj][m][n][0] * r2 * gv.x;
                o.y = bf2f((u16)(hb.x >> 16)) + acc[ai][bj][m][n][1] * r2 * gv.y;
                o.z = bf2f((u16)(hb.y & 0xFFFF)) + acc[ai][bj][m][n][2] * r2 * gv.z;
                o.w = bf2f((u16)(hb.y >> 16)) + acc[ai][bj][m][n][3] * r2 * gv.w;
                *(float4*)(p.out + idx) = o;
              }
            asm volatile("" ::: "memory");
          }
      }
    }
    asm volatile("s_waitcnt vmcnt(0)" ::: "memory");
    __syncthreads();
  }
  if (EPI == 0) {
    const int G = (int)gridDim.x, rem = (nM * nN) % G;
    const int first = rem, nE = G - rem;
    const int me = (int)blockIdx.x - first;
    if (me >= 0)
      for (int t2 = me; t2 < 256; t2 += nE) e1_tile(ws, t2, acc);
  }
}

__device__ __forceinline__ void transpose_tile(const float* __restrict__ src, int R, int C, u16* __restrict__ dst, int tr, int tc) {
  float* tile = (float*)smem;
  const int tid = threadIdx.x;
  const int r0 = tr * 64, c0 = tc * 64;
  {
    int cc = tid & 63, rr = tid >> 6;
#pragma unroll
    for (int i = 0; i < 8; ++i) {
      int r = rr + 8 * i;
      float v = 0.f;
      if (c0 + cc < C) v = src[(size_t)(r0 + r) * C + c0 + cc];
      tile[r * 65 + cc] = v;
    }
  }
  __syncthreads();
  {
    int rr = tid & 63, cc = tid >> 6;
#pragma unroll
    for (int i = 0; i < 8; ++i) {
      int c = cc + 8 * i;
      dst[(size_t)(c0 + c) * R + r0 + rr] = f2bf(tile[rr * 65 + c]);
    }
  }
  __syncthreads();
}

__device__ __forceinline__ void phase_prep(const Params& p) {
  unsigned char* ws = p.ws;
  const int tid = threadIdx.x, lane = tid & 63, wave = tid >> 6;
  const int nblk = gridDim.x, bid = blockIdx.x;
  const size_t gtid = (size_t)bid * NTHR + tid, gn = (size_t)nblk * NTHR;
  {
    u16* XN = (u16*)(ws + WS_XN);
    float4 g4[4];
#pragma unroll
    for (int i = 0; i < 4; ++i) g4[i] = ((const float4*)p.pre_norm)[lane + 64 * i];
    for (int row0 = (bid * 8 + wave) * 4; row0 < MTOK; row0 += nblk * 8 * 4) {
      float4 v[4][4];
      float ss[4];
#pragma unroll
      for (int q = 0; q < 4; ++q) {
        const float4* xr = (const float4*)(p.x + (size_t)(row0 + q) * 1024);
#pragma unroll
        for (int i = 0; i < 4; ++i) v[q][i] = xr[lane + 64 * i];
      }
#pragma unroll
      for (int q = 0; q < 4; ++q) {
        float s = 0.f;
#pragma unroll
        for (int i = 0; i < 4; ++i) s += v[q][i].x * v[q][i].x + v[q][i].y * v[q][i].y + v[q][i].z * v[q][i].z + v[q][i].w * v[q][i].w;
        ss[q] = s;
      }
#pragma unroll
      for (int o = 32; o > 0; o >>= 1) {
#pragma unroll
        for (int q = 0; q < 4; ++q) ss[q] += __shfl_xor(ss[q], o);
      }
#pragma unroll
      for (int q = 0; q < 4; ++q) {
        float r = rsqrtf(ss[q] * (1.f / 1024.f) + EPSV);
#pragma unroll
        for (int i = 0; i < 4; ++i) {
          uint2 o;
          o.x = pk2(v[q][i].x * r * g4[i].x, v[q][i].y * r * g4[i].y);
          o.y = pk2(v[q][i].z * r * g4[i].z, v[q][i].w * r * g4[i].w);
          *(uint2*)(XN + (size_t)(row0 + q) * 1024 + (lane + 64 * i) * 4) = o;
        }
      }
    }
  }
  {
    u16* PB = (u16*)(ws + WS_PB);
    const float4* ps = (const float4*)p.p;
    for (size_t i = gtid; i < (size_t)MTOK * 256 / 4; i += gn) {
      float4 v = ps[i];
      uint2 o;
      o.x = pk2(v.x, v.y);
      o.y = pk2(v.z, v.w);
      *(uint2*)(PB + i * 4) = o;
    }
  }
  {
    float* RC = (float*)(ws + WS_ROPEC);
    float* RS = (float*)(ws + WS_ROPES);
    float* SS = (float*)(ws + WS_SS1);
    for (size_t i = gtid; i < (size_t)SEQ * 8; i += gn) {
      int pos = (int)(i >> 3), fi = (int)(i & 7);
      float inv = fi == 0   ? 1.0f
                  : fi == 1 ? 0.1939227432012558f
                  : fi == 2 ? 0.03760603070259094f
                  : fi == 3 ? 0.007292664609849453f
                  : fi == 4 ? 0.0014142135623842478f
                  : fi == 5 ? 0.00027424818836152554f
                  : fi == 6 ? 5.318296098266728e-05f
                            : 1.0313386155758053e-05f;
      float ang = (float)pos * inv;
      double rev = (double)ang * 0.15915494309189535;
      rev -= floor(rev);
      float fr = (float)rev;
      RC[i] = __builtin_amdgcn_cosf(fr);
      RS[i] = __builtin_amdgcn_sinf(fr);
    }
    for (size_t i = gtid; i < (size_t)MTOK * 2; i += gn) SS[i] = 0.f;
  }
  {
    const int n_in = 16 * 56, n_out = 256, n_g = 256, n_p = 4 * 16, n_w1 = 32 * 2, n_w2 = 2;
    const int total = n_in + n_out + n_g + n_p + 2 * n_w1 + 2 * n_w2;
    for (int t = bid; t < total; t += nblk) {
      int u = t;
      const float* src;
      u16* dst;
      int R, C, tr, tc;
      if (u < n_in) { src = p.w_in; R = 1024; C = PP; dst = (u16*)(ws + WS_WTIN); tr = u / 56; tc = u % 56; }
      else if ((u -= n_in) < n_out) { src = p.w_out; R = 1024; C = 1024; dst = (u16*)(ws + WS_WTOUT); tr = u / 16; tc = u % 16; }
      else if ((u -= n_out) < n_g) { src = p.ple_gate; R = 1024; C = 1024; dst = (u16*)(ws + WS_WTG); tr = u / 16; tc = u % 16; }
      else if ((u -= n_g) < n_p) { src = p.ple_proj; R = 256; C = 1024; dst = (u16*)(ws + WS_WTP); tr = u / 16; tc = u % 16; }
      else if ((u -= n_p) < n_w1) { src = p.w1k; R = 2048; C = 128; dst = (u16*)(ws + WS_W1K); tr = u / 2; tc = u % 2; }
      else if ((u -= n_w1) < n_w1) { src = p.w1v; R = 2048; C = 128; dst = (u16*)(ws + WS_W1V); tr = u / 2; tc = u % 2; }
      else if ((u -= n_w1) < n_w2) { src = p.w2k; R = 128; C = 64; dst = (u16*)(ws + WS_W2K); tr = u; tc = 0; }
      else { u -= n_w2; src = p.w2v; R = 128; C = 64; dst = (u16*)(ws + WS_W2V); tr = u; tc = 0; }
      transpose_tile(src, R, C, dst, tr, tc);
    }
  }
}

__device__ __forceinline__ void phase2_rope(const Params& p) {
  unsigned char* ws = p.ws;
  u16* PJ = (u16*)(ws + WS_PROJ);
  const float* RC = (const float*)(ws + WS_ROPEC);
  const float* RS = (const float*)(ws + WS_ROPES);
  const size_t gtid = (size_t)blockIdx.x * NTHR + threadIdx.x, gn = (size_t)gridDim.x * NTHR;
  for (size_t i = gtid; i < (size_t)MTOK * 12; i += gn) {
    int tok = (int)(i / 12), slot = (int)(i % 12);
    int col = slot < 8 ? C_NQ + slot * 64 : (slot < 10 ? C_KS + (slot - 8) * 64 : C_KW + (slot - 10) * 64);
    int pos = tok & (SEQ - 1);
    u16* ptr = PJ + (size_t)tok * PP + col;
    U8 a, b, oa, ob;
    a.u = *(const uint4*)ptr;
    b.u = *(const uint4*)(ptr + 8);
    float4 c0 = *(const float4*)(RC + pos * 8), c1 = *(const float4*)(RC + pos * 8 + 4);
    float4 s0 = *(const float4*)(RS + pos * 8), s1 = *(const float4*)(RS + pos * 8 + 4);
    float cs[8] = {c0.x, c0.y, c0.z, c0.w, c1.x, c1.y, c1.z, c1.w};
    float sn[8] = {s0.x, s0.y, s0.z, s0.w, s1.x, s1.y, s1.z, s1.w};
#pragma unroll
    for (int k = 0; k < 8; ++k) {
      float x1 = bf2f(a.s[k]), x2 = bf2f(b.s[k]);
      oa.s[k] = f2bf(x1 * cs[k] - x2 * sn[k]);
      ob.s[k] = f2bf(x2 * cs[k] + x1 * sn[k]);
    }
    *(uint4*)ptr = oa.u;
    *(uint4*)(ptr + 8) = ob.u;
  }
}

__device__ __forceinline__ void phase2_vtrans(const Params& p) {
  unsigned char* ws = p.ws;
  const u16* PJ = (const u16*)(ws + WS_PROJ);
  u16* T = (u16*)smem;
  const int tid = threadIdx.x;
  for (int it = blockIdx.x; it < 1024; it += gridDim.x) {
    int which = it >> 9, b = (it >> 8) & 1, h = (it >> 7) & 1, tile = it & 127;
    int col0 = (which ? C_VW : C_VS) + h * 64;
    u16* dst = (u16*)(ws + (which ? WS_VWT : WS_VST));
    {
      int row = tid >> 3, ch = tid & 7;
      uint4 v = *(const uint4*)(PJ + (size_t)(b * SEQ + tile * 64 + row) * PP + col0 + ch * 8);
      *(uint4*)(T + row * 72 + ch * 8) = v;
    }
    __syncthreads();
    {
      int d = tid >> 3, tc = tid & 7;
      U8 o;
#pragma unroll
      for (int i = 0; i < 8; ++i) o.s[i] = T[(tc * 8 + i) * 72 + d];
      *(uint4*)(dst + ((size_t)(b * 2 + h) * 64 + d) * SEQ + tile * 64 + tc * 8) = o.u;
    }
    __syncthreads();
  }
}

__device__ __forceinline__ void phase2_compress(const Params& p) {
  unsigned char* ws = p.ws;
  const u16* PJ = (const u16*)(ws + WS_PROJ);
  const float* RC = (const float*)(ws + WS_ROPEC);
  const float* RS = (const float*)(ws + WS_ROPES);
  constexpr int AST = 2064;
  u16* AL = (u16*)smem;
  u16* H = (u16*)(smem + 16 * AST * 2);
  float* OF = (float*)(smem + 16 * AST * 2 + 16 * 136 * 2);
  const int tid = threadIdx.x, lane = tid & 63, w = tid >> 6, fr = lane & 15, fq = lane >> 4;
  for (int it = blockIdx.x; it < 256; it += gridDim.x) {
    int which = it >> 7, b = (it >> 6) & 1, h = (it >> 5) & 1, ct = it & 31;
    const int c0 = ct * 16;
    const int colbase = (which ? C_VC : C_KC) + h * 64;
    const float* pos = which ? p.pos_v : p.pos_k;
    const u16* W1 = (const u16*)(ws + (which ? WS_W1V : WS_W1K));
    const u16* W2 = (const u16*)(ws + (which ? WS_W2V : WS_W2K));
    const int n0 = w * 16;
    const u16* wrow = W1 + (size_t)(n0 + fr) * 2048 + fq * 8;
    U8 wbuf[2][16];
#pragma unroll
    for (int i = 0; i < 16; ++i) wbuf[0][i].u = *(const uint4*)(wrow + i * 32);
    {
      U8 xq[5];
#pragma unroll
      for (int q = 0; q < 5; ++q) {
        int u = tid + q * NTHR;
        u = u < 272 * 8 ? u : 272 * 8 - 1;
        int tok = c0 * 16 + (u >> 3);
        tok = tok > SEQ - 1 ? SEQ - 1 : tok;
        xq[q].u = *(const uint4*)(PJ + (size_t)(b * SEQ + tok) * PP + colbase + (u & 7) * 8);
      }
#pragma unroll
      for (int q = 0; q < 5; ++q) {
        const int u = tid + q * NTHR;
        if (u < 272 * 8) {
          const int tl = u >> 3, ch = u & 7;
          const int cl = tl >> 4, l = tl & 15;
          float xv[8];
#pragma unroll
          for (int k = 0; k < 8; ++k) xv[k] = bf2f(xq[q].s[k]);
          if (cl <= 15) {
            float4 p0 = *(const float4*)(pos + l * 64 + ch * 8), p1 = *(const float4*)(pos + l * 64 + ch * 8 + 4);
            uint4 o;
            o.x = pk2(xv[0] + p0.x, xv[1] + p0.y);
            o.y = pk2(xv[2] + p0.z, xv[3] + p0.w);
            o.z = pk2(xv[4] + p1.x, xv[5] + p1.y);
            o.w = pk2(xv[6] + p1.z, xv[7] + p1.w);
            *(uint4*)(AL + cl * AST + l * 64 + ch * 8) = o;
          }
          if (cl >= 1) {
            int l2 = l + 16;
            float4 p0 = *(const float4*)(pos + l2 * 64 + ch * 8), p1 = *(const float4*)(pos + l2 * 64 + ch * 8 + 4);
            uint4 o;
            o.x = pk2(xv[0] + p0.x, xv[1] + p0.y);
            o.y = pk2(xv[2] + p0.z, xv[3] + p0.w);
            o.z = pk2(xv[4] + p1.x, xv[5] + p1.y);
            o.w = pk2(xv[6] + p1.z, xv[7] + p1.w);
            *(uint4*)(AL + (cl - 1) * AST + l2 * 64 + ch * 8) = o;
          }
        }
      }
    }
    __syncthreads();
    f32x4 acc = {0.f, 0.f, 0.f, 0.f};
    const u16* arow = AL + fr * AST + fq * 8;
#pragma unroll
    for (int bt = 0; bt < 4; ++bt) {
      if (bt + 1 < 4) {
#pragma unroll
        for (int i = 0; i < 16; ++i) wbuf[(bt + 1) & 1][i].u = *(const uint4*)(wrow + ((bt + 1) * 16 + i) * 32);
      }
#pragma unroll
      for (int i = 0; i < 16; ++i) {
        U8 aa;
        aa.u = *(const uint4*)(arow + (bt * 16 + i) * 32);
        acc = __builtin_amdgcn_mfma_f32_16x16x32_bf16(aa.v, wbuf[bt & 1][i].v, acc, 0, 0, 0);
      }
    }
#pragma unroll
    for (int j = 0; j < 4; ++j) H[(fq * 4 + j) * 136 + n0 + fr] = f2bf(siluf_(acc[j]));
    __syncthreads();
    if (w < 4) {
      f32x4 a2 = {0.f, 0.f, 0.f, 0.f};
#pragma unroll
      for (int ks = 0; ks < 4; ++ks) {
        U8 ha, wb;
        ha.u = *(const uint4*)(H + fr * 136 + ks * 32 + fq * 8);
        wb.u = *(const uint4*)(W2 + (size_t)(w * 16 + fr) * 128 + ks * 32 + fq * 8);
        a2 = __builtin_amdgcn_mfma_f32_16x16x32_bf16(ha.v, wb.v, a2, 0, 0, 0);
      }
#pragma unroll
      for (int j = 0; j < 4; ++j) OF[(fq * 4 + j) * 64 + w * 16 + fr] = a2[j];
    }
    __syncthreads();
    {
      int cl = tid >> 5, dd = tid & 31;
      int c = c0 + cl;
      float v0 = OF[cl * 64 + dd], v1 = OF[cl * 64 + dd + 32];
      if (which == 0) {
        if (dd < 16) {
          int partner = dd < 8 ? dd + 8 : dd - 8;
          float y = OF[cl * 64 + partner];
          int ps = c * 16 + 31;
          ps = ps > SEQ - 1 ? SEQ - 1 : ps;
          float cs = RC[ps * 8 + (dd & 7)], sn = RS[ps * 8 + (dd & 7)];
          v0 = dd < 8 ? v0 * cs - y * sn : v0 * cs + y * sn;
        }
        u16* KC = (u16*)(ws + WS_KC);
        KC[((size_t)(b * 2 + h) * 512 + c) * 64 + dd] = f2bf(v0);
        KC[((size_t)(b * 2 + h) * 512 + c) * 64 + dd + 32] = f2bf(v1);
      } else {
        u16* VCT = (u16*)(ws + WS_VCT);
        VCT[((size_t)(b * 2 + h) * 64 + dd) * 512 + c] = f2bf(v0);
        VCT[((size_t)(b * 2 + h) * 64 + dd + 32) * 512 + c] = f2bf(v1);
      }
    }
    __syncthreads();
  }
}

__device__ __forceinline__ float logsig(float u) { return fminf(u, 0.f) - __logf(1.f + __expf(-fabsf(u))); }

__device__ __forceinline__ void phase2_gla1(const Params& p) {
  unsigned char* ws = p.ws;
  const u16* PJ = (const u16*)(ws + WS_PROJ);
  float* BC = (float*)(ws + WS_BCUM);
  u16* DS = (u16*)(ws + WS_DS);
  float* DEC = (float*)(ws + WS_DEC);
  float* GA = (float*)smem;
  float* PART = GA + 1024;
  u16* KT = (u16*)(PART + 512);
  u16* VT = KT + 256 * 72;
  const int tid = threadIdx.x, lane = tid & 63, w = tid >> 6, r = lane & 31, hh = lane >> 5;
  for (int it = blockIdx.x; it < 256; it += gridDim.x) {
    const int b = it >> 7, c = it & 127;
    const size_t tok0 = (size_t)b * SEQ + c * 64;
    for (int i = tid; i < 1024; i += NTHR) GA[i] = bf2f(PJ[(tok0 + (i >> 4)) * PP + C_GA + (i & 15)]);
    const int col = tid & 255, tg = tid >> 8;
    float au[16];
#pragma unroll
    for (int rr = 0; rr < 16; ++rr) au[rr] = p.a_up[rr * 256 + col];
    const float bias = p.a_bias[col];
    u16 kraw[32];
#pragma unroll
    for (int tt = 0; tt < 32; ++tt) kraw[tt] = PJ[(tok0 + tg * 32 + tt) * PP + C_GK + col];
    {
      const int vc = tid;
#pragma unroll
      for (int t8 = 0; t8 < 8; ++t8) {
        U8 o;
#pragma unroll
        for (int i = 0; i < 8; ++i) o.s[i] = PJ[(tok0 + t8 * 8 + i) * PP + C_GV + vc];
        *(uint4*)(VT + vc * 72 + t8 * 8) = o.u;
      }
    }
    __syncthreads();
    float pre[32];
    {
      float run = 0.f;
#pragma unroll
      for (int tt = 0; tt < 32; ++tt) {
        const int t = tg * 32 + tt;
        float u = bias;
#pragma unroll
        for (int rr = 0; rr < 16; ++rr) u += GA[t * 16 + rr] * au[rr];
        run += logsig(u) * (1.f / 16.f);
        pre[tt] = run;
      }
      PART[tg * 256 + col] = run;
    }
    __syncthreads();
    {
      const float p0 = PART[col], p1 = PART[256 + col];
      const float off = tg ? p0 : 0.f, blast = p0 + p1;
#pragma unroll
      for (int t8 = 0; t8 < 4; ++t8) {
        U8 o;
#pragma unroll
        for (int i = 0; i < 8; ++i) {
          const int tt = t8 * 8 + i;
          const float bv = off + pre[tt];
          BC[(tok0 + tg * 32 + tt) * 256 + col] = bv;
          o.s[i] = f2bf(bf2f(kraw[tt]) * __expf(blast - bv));
        }
        *(uint4*)(KT + col * 72 + tg * 32 + t8 * 8) = o.u;
      }
      if (tg == 0) DEC[((size_t)((b * 4 + (col >> 6)) * 128 + c)) * 64 + (col & 63)] = __expf(blast);
    }
    __syncthreads();
    {
      const int h = w >> 1, kt = w & 1;
      bf16x8 afr[4];
#pragma unroll
      for (int ts = 0; ts < 4; ++ts) {
        U8 a;
        a.u = *(const uint4*)(KT + (h * 64 + kt * 32 + r) * 72 + ts * 16 + hh * 8);
        afr[ts] = a.v;
      }
      const size_t item = (size_t)((b * 4 + h) * 128 + c);
#pragma unroll 1
      for (int vt = 0; vt < 4; ++vt) {
        f32x16 acc;
#pragma unroll
        for (int i = 0; i < 16; ++i) acc[i] = 0.f;
#pragma unroll
        for (int ts = 0; ts < 4; ++ts) {
          U8 bq;
          bq.u = *(const uint4*)(VT + (h * 128 + vt * 32 + r) * 72 + ts * 16 + hh * 8);
          acc = mfma32(afr[ts], bq.v, acc);
        }
#pragma unroll
        for (int i = 0; i < 16; ++i) {
          int kk = kt * 32 + (i & 3) + 8 * (i >> 2) + 4 * hh;
          DS[item * 8192 + kk * 128 + vt * 32 + r] = f2bf(acc[i]);
        }
      }
    }
    __syncthreads();
  }
}

__device__ __forceinline__ void phase3_scan(const Params& p) {
  unsigned char* ws = p.ws;
  u16* DS = (u16*)(ws + WS_DS);
  const float* DEC = (const float*)(ws + WS_DEC);
  const size_t gtid = (size_t)blockIdx.x * NTHR + threadIdx.x, gn = (size_t)gridDim.x * NTHR;
  for (size_t e = gtid; e < 65536; e += gn) {
    int bh = (int)(e >> 13), kv = (int)(e & 8191), k = kv >> 7;
    float S = 0.f;
    for (int c0 = 0; c0 < 128; c0 += 32) {
      float tmp[32], dc[32];
#pragma unroll
      for (int i = 0; i < 32; ++i) {
        tmp[i] = bf2f(DS[((size_t)(bh * 128 + c0 + i)) * 8192 + kv]);
        dc[i] = DEC[(size_t)(bh * 128 + c0 + i) * 64 + k];
      }
#pragma unroll
      for (int i = 0; i < 32; ++i) {
        DS[((size_t)(bh * 128 + c0 + i)) * 8192 + kv] = f2bf(S);
        S = dc[i] * S + tmp[i];
      }
    }
  }
}

__device__ __forceinline__ void phase4_gla3(const Params& p) {
  unsigned char* ws = p.ws;
  const u16* PJ = (const u16*)(ws + WS_PROJ);
  const float* BC = (const float*)(ws + WS_BCUM);
  const u16* DS = (const u16*)(ws + WS_DS);
  u16* MIX = (u16*)(ws + WS_XN);
  u16* QT = (u16*)smem;
  u16* KP = QT + 2 * 64 * 72;
  u16* ST = KP + 2 * 64 * 72;
  u16* VT = ST + 2 * 128 * 72;
  float* RED = (float*)(VT + 2 * 128 * 72);
  const int tid = threadIdx.x, lane = tid & 63, w = tid >> 6, r = lane & 31, hh = lane >> 5;
  for (int it = blockIdx.x; it < 512; it += gridDim.x) {
    const int b = it >> 8, c = (it >> 1) & 127, hp = it & 1;
    const size_t tok0 = (size_t)b * SEQ + c * 64;
    {
      const int colq = tid & 127, tg = tid >> 7;
      const int hd = colq >> 6, k = colq & 63, hcol = (hp * 2 + hd) * 64 + k;
      float bv[16];
      u16 qv[16], kv[16];
#pragma unroll
      for (int tt = 0; tt < 16; ++tt) {
        const size_t tok = tok0 + tg * 16 + tt;
        bv[tt] = BC[tok * 256 + hcol];
        qv[tt] = PJ[tok * PP + C_GQ + hcol];
        kv[tt] = PJ[tok * PP + C_GK + hcol];
      }
      const int vcol = tid & 255, half = tid >> 8;
      const int hd2 = vcol >> 7, v = vcol & 127;
      const size_t item = (size_t)((b * 4 + hp * 2 + hd2) * 128 + c);
      u16 sv[32];
      u16 vv[32];
#pragma unroll
      for (int i = 0; i < 32; ++i) {
        sv[i] = DS[item * 8192 + (half * 32 + i) * 128 + v];
        vv[i] = PJ[(tok0 + half * 32 + i) * PP + C_GV + (hp * 2 + hd2) * 128 + v];
      }
#pragma unroll
      for (int tt = 0; tt < 16; ++tt) {
        const int t = tg * 16 + tt;
        QT[(hd * 64 + t) * 72 + k] = f2bf(bf2f(qv[tt]) * 0.125f * __expf(bv[tt]));
        KP[(hd * 64 + t) * 72 + k] = f2bf(bf2f(kv[tt]) * __expf(-bv[tt]));
      }
#pragma unroll
      for (int q8 = 0; q8 < 4; ++q8) {
        U8 so, vo;
#pragma unroll
        for (int i = 0; i < 8; ++i) so.s[i] = sv[q8 * 8 + i];
#pragma unroll
        for (int i = 0; i < 8; ++i) vo.s[i] = vv[q8 * 8 + i];
        *(uint4*)(ST + (hd2 * 128 + v) * 72 + half * 32 + q8 * 8) = so.u;
        *(uint4*)(VT + (hd2 * 128 + v) * 72 + half * 32 + q8 * 8) = vo.u;
      }
    }
    __syncthreads();
    const int itile = w & 1, vt = w >> 1;
    uint2 zpre[2][4];
#pragma unroll
    for (int hd = 0; hd < 2; ++hd)
#pragma unroll
      for (int q4 = 0; q4 < 4; ++q4)
        zpre[hd][q4] = *(const uint2*)(PJ + (tok0 + itile * 32 + r) * PP + C_GZ + (hp * 2 + hd) * 128 + vt * 32 + 8 * q4 + 4 * hh);
    f32x16 o[2];
#pragma unroll
    for (int hd = 0; hd < 2; ++hd) {
      const u16* QTh = QT + hd * 64 * 72;
      const u16* KPh = KP + hd * 64 * 72;
      const u16* STh = ST + hd * 128 * 72;
      const u16* VTh = VT + hd * 128 * 72;
#pragma unroll
      for (int i = 0; i < 16; ++i) o[hd][i] = 0.f;
      bf16x8 qfr[4];
#pragma unroll
      for (int ks = 0; ks < 4; ++ks) {
        U8 q;
        q.u = *(const uint4*)(QTh + (itile * 32 + r) * 72 + ks * 16 + hh * 8);
        qfr[ks] = q.v;
        U8 a;
        a.u = *(const uint4*)(STh + (vt * 32 + r) * 72 + ks * 16 + hh * 8);
        o[hd] = mfma32(a.v, q.v, o[hd]);
      }
      for (int jt = 0; jt <= itile; ++jt) {
        f32x16 s;
#pragma unroll
        for (int i = 0; i < 16; ++i) s[i] = 0.f;
#pragma unroll
        for (int ks = 0; ks < 4; ++ks) {
          U8 a;
          a.u = *(const uint4*)(KPh + (jt * 32 + r) * 72 + ks * 16 + hh * 8);
          s = mfma32(a.v, qfr[ks], s);
        }
        const int ii = itile * 32 + r;
#pragma unroll
        for (int i = 0; i < 16; ++i) {
          int j = jt * 32 + (i & 3) + 8 * (i >> 2) + 4 * hh;
          if (j > ii) s[i] = 0.f;
        }
#pragma unroll
        for (int s2 = 0; s2 < 2; ++s2) {
          U8 pb, va;
          pb.u.x = pk2(s[8 * s2 + 0], s[8 * s2 + 1]);
          pb.u.y = pk2(s[8 * s2 + 2], s[8 * s2 + 3]);
          pb.u.z = pk2(s[8 * s2 + 4], s[8 * s2 + 5]);
          pb.u.w = pk2(s[8 * s2 + 6], s[8 * s2 + 7]);
          const u16* vp = VTh + (vt * 32 + r) * 72 + jt * 32 + s2 * 16 + hh * 4;
          va.h[0] = *(const uint2*)vp;
          va.h[1] = *(const uint2*)(vp + 8);
          o[hd] = mfma32(va.v, pb.v, o[hd]);
        }
      }
      float ss = 0.f;
#pragma unroll
      for (int i = 0; i < 16; ++i) ss += o[hd][i] * o[hd][i];
      ss += __shfl_xor(ss, 32);
      if (hh == 0) RED[(hd * 4 + vt) * 64 + itile * 32 + r] = ss;
    }
    __syncthreads();
#pragma unroll
    for (int hd = 0; hd < 2; ++hd) {
      const int h = hp * 2 + hd;
      const int ti = itile * 32 + r;
      const float* R4 = RED + hd * 256;
      float tot = R4[ti] + R4[64 + ti] + R4[128 + ti] + R4[192 + ti];
      float rstd = rsqrtf(tot * (1.f / 128.f) + EPSV);
      const size_t tok = tok0 + ti;
#pragma unroll
      for (int q4 = 0; q4 < 4; ++q4) {
        int v0 = vt * 32 + 8 * q4 + 4 * hh;
        uint2 zz = zpre[hd][q4];
        float4 gn = *(const float4*)(p.gnorm + v0);
        float z0 = bf2f((u16)(zz.x & 0xFFFF)), z1 = bf2f((u16)(zz.x >> 16)), z2 = bf2f((u16)(zz.y & 0xFFFF)),
              z3 = bf2f((u16)(zz.y >> 16));
        uint2 ov;
        ov.x = pk2(o[hd][4 * q4 + 0] * rstd * gn.x * siluf_(z0), o[hd][4 * q4 + 1] * rstd * gn.y * siluf_(z1));
        ov.y = pk2(o[hd][4 * q4 + 2] * rstd * gn.z * siluf_(z2), o[hd][4 * q4 + 3] * rstd * gn.w * siluf_(z3));
        *(uint2*)(MIX + tok * 1024 + h * 128 + v0) = ov;
      }
    }
    __syncthreads();
  }
}

constexpr int NSA_BUF = 18432;
constexpr int NSA_IMP_OFF = 2 * NSA_BUF;
constexpr int NSA_SEL_OFF = NSA_IMP_OFF + 64 * 128 * 4;
constexpr int NSA_OFIN_OFF = NSA_SEL_OFF + 1024;

__device__ __forceinline__ void tile_load(const u16* kp, int kpitch, const u16* vp, int vpitch, uint4& kr, uint4& vr) {
  int row = threadIdx.x >> 3, ch = threadIdx.x & 7;
  kr = *(const uint4*)(kp + (size_t)row * kpitch + ch * 8);
  vr = *(const uint4*)(vp + (size_t)row * vpitch + ch * 8);
}
__device__ __forceinline__ void tile_store(unsigned char* buf, uint4 kr, uint4 vr) {
  int row = threadIdx.x >> 3, ch = threadIdx.x & 7;
  *(uint4*)(buf + row * 144 + ch * 16) = kr;
  unsigned char* vb = buf + 9216 + row * 144 + (ch >> 1) * 32 + (ch & 1) * 8;
  *(uint2*)vb = make_uint2(vr.x, vr.y);
  *(uint2*)(vb + 16) = make_uint2(vr.z, vr.w);
}

template <int KIND>
__device__ __forceinline__ void nsa_segment(const u16* kp0, size_t kstride, int kpitch, const u16* vp0, size_t vstride,
                                            int vpitch, int nsteps, const bf16x8 (&qf)[4], f32x16 (&o)[2], float& mrun,
                                            float& lrun, int m_tile, int tl, int imax, unsigned long long sel_lo, unsigned long long sel_hi, float cm,
                                            float cinvl, int tokl, int g, int kb0) {
  const int lane = threadIdx.x & 63, r = lane & 31, hh = lane >> 5;
  float* imp = (float*)(smem + NSA_IMP_OFF);
  uint4 krA, vrA, krB, vrB;
  tile_load(kp0, kpitch, vp0, vpitch, krA, vrA);
  tile_store(smem, krA, vrA);
  {
    const int t1 = nsteps > 1 ? 1 : 0;
    tile_load(kp0 + (size_t)t1 * kstride, kpitch, vp0 + (size_t)t1 * vstride, vpitch, krA, vrA);
  }
  __syncthreads();
  auto body = [&](int s, uint4& k_issue, uint4& v_issue, uint4& k_store, uint4& v_store) {
    unsigned char* cur = smem + (s & 1) * NSA_BUF;
    unsigned char* nxt = smem + ((s + 1) & 1) * NSA_BUF;
    {
      const int tn = (s + 2 < nsteps) ? s + 2 : nsteps - 1;
      tile_load(kp0 + (size_t)tn * kstride, kpitch, vp0 + (size_t)tn * vstride, vpitch, k_issue, v_issue);
    }
    bool masked = false, rowvalid = true;
    int hi = 63, lo = -1;
    if (KIND <= 1) {
      masked = true;
      hi = imax - 64 * s;
      rowvalid = hi >= 0;
    } else if (KIND == 2) {
      if (s == m_tile) {
        masked = true;
        hi = tl;
      } else {
        unsigned long long sw = s < 64 ? sel_lo : sel_hi;
        rowvalid = (sw >> (s & 63)) & 1ull;
      }
    } else {
      int kb = kb0 + s;
      if (kb == m_tile - 8) {
        masked = true;
        lo = tl;
      } else if (kb == m_tile) {
        masked = true;
        hi = tl;
      }
    }
    if (s < nsteps && __ballot(rowvalid) != 0ull) {
      f32x16 sc[2];
      U8 kf[8];
#pragma unroll
      for (int kt = 0; kt < 2; ++kt)
#pragma unroll
        for (int ds = 0; ds < 4; ++ds) kf[kt * 4 + ds].u = *(const uint4*)(cur + (kt * 32 + r) * 144 + ds * 32 + hh * 16);
      __builtin_amdgcn_sched_barrier(0);
#pragma unroll
      for (int kt = 0; kt < 2; ++kt) {
#pragma unroll
        for (int i = 0; i < 16; ++i) sc[kt][i] = 0.f;
#pragma unroll
        for (int ds = 0; ds < 4; ++ds) sc[kt] = mfma32(kf[kt * 4 + ds].v, qf[ds], sc[kt]);
      }
      U8 vf[8];
      if (KIND >= 1) {
#pragma unroll
        for (int kt = 0; kt < 2; ++kt)
#pragma unroll
          for (int s2 = 0; s2 < 2; ++s2)
#pragma unroll
            for (int dt = 0; dt < 2; ++dt) {
              vf[(kt * 2 + s2) * 2 + dt].u = *(const uint4*)(cur + 9216 + (dt * 32 + r) * 144 + (kt * 2 + s2) * 32 + hh * 16);
            }
      }
      __builtin_amdgcn_sched_barrier(0);
      const float NEG_INF = -__builtin_inff();
      if (KIND == 1) {
#pragma unroll
        for (int kt = 0; kt < 2; ++kt)
#pragma unroll
          for (int i = 0; i < 16; ++i) {
            int kl = kt * 32 + (i & 3) + 8 * (i >> 2) + 4 * hh;
            float pv = ex2(sc[kt][i] * QSCALE_L2 - cm) * cinvl;
            sc[kt][i] = (kl <= hi) ? pv : 0.f;
          }
#pragma unroll
        for (int kt = 0; kt < 2; ++kt)
#pragma unroll
          for (int q4 = 0; q4 < 4; ++q4) {
            float s4 = sc[kt][4 * q4] + sc[kt][4 * q4 + 1] + sc[kt][4 * q4 + 2] + sc[kt][4 * q4 + 3];
            float sp = sc[kt][4 * q4 + 3];
            s4 = quad_sum(s4);
            sp = quad_sum(sp);
            if (g == 0) {
              int jb = (64 * s + kt * 32 + 8 * q4 + 4 * hh) >> 2;
              atomicAdd(&imp[tokl * 128 + jb], s4);
              if (jb + 1 < 128) atomicAdd(&imp[tokl * 128 + jb + 1], sp);
            }
          }
      } else {
        float mx = NEG_INF;
        if (masked) {
#pragma unroll
          for (int kt = 0; kt < 2; ++kt)
#pragma unroll
            for (int i = 0; i < 16; ++i) {
              int kl = kt * 32 + (i & 3) + 8 * (i >> 2) + 4 * hh;
              bool ok = (kl <= hi) && (kl > lo);
              sc[kt][i] = ok ? sc[kt][i] : NEG_INF;
              mx = fmaxf(mx, sc[kt][i]);
            }
        } else {
#pragma unroll
          for (int kt = 0; kt < 2; ++kt)
#pragma unroll
            for (int i = 0; i < 16; ++i) mx = fmaxf(mx, sc[kt][i]);
          if (!rowvalid) mx = NEG_INF;
        }
        mx = fmaxf(mx, __shfl_xor(mx, 32));
        const float mxc = mx * QSCALE_L2;
        const bool need = mxc > mrun + 8.f;
        if (__ballot(need) != 0ull) {
          float mnew = need ? mxc : mrun;
          float alpha = ex2(mrun - mnew);
          lrun *= alpha;
          mrun = mnew;
          if (KIND >= 2) {
#pragma unroll
            for (int dt = 0; dt < 2; ++dt)
#pragma unroll
              for (int i = 0; i < 16; ++i) o[dt][i] *= alpha;
          }
        }
        float moff = (masked || rowvalid) ? mrun : __builtin_inff();
        float psum = 0.f;
#pragma unroll
        for (int kt = 0; kt < 2; ++kt)
#pragma unroll
          for (int i = 0; i < 16; ++i) {
            float pv = ex2(sc[kt][i] * QSCALE_L2 - moff);
            sc[kt][i] = pv;
            psum += pv;
          }
        lrun += psum;
      }
      if (KIND >= 1) {
#pragma unroll
        for (int kt = 0; kt < 2; ++kt)
#pragma unroll
          for (int s2 = 0; s2 < 2; ++s2) {
            U8 pb;
            pb.u.x = pk2(sc[kt][8 * s2 + 0], sc[kt][8 * s2 + 1]);
            pb.u.y = pk2(sc[kt][8 * s2 + 2], sc[kt][8 * s2 + 3]);
            pb.u.z = pk2(sc[kt][8 * s2 + 4], sc[kt][8 * s2 + 5]);
            pb.u.w = pk2(sc[kt][8 * s2 + 6], sc[kt][8 * s2 + 7]);
#pragma unroll
            for (int dt = 0; dt < 2; ++dt) o[dt] = mfma32(vf[(kt * 2 + s2) * 2 + dt].v, pb.v, o[dt]);
          }
      }
    }
    tile_store(nxt, k_store, v_store);
    __syncthreads();
  };
  const int nst2 = (nsteps + 1) & ~1;
  for (int s = 0; s < nst2; s += 2) {
    body(s, krB, vrB, krA, vrA);
    body(s + 1, krA, vrA, krB, vrB);
  }
}

__device__ __forceinline__ void nsa_item(const Params& p, int b, int kvh, int m) {
  unsigned char* ws = p.ws;
  const u16* PJ = (const u16*)(ws + WS_PROJ);
  u16* MIX = (u16*)(ws + WS_XN);
  int tid = threadIdx.x;
  asm volatile("" : "+v"(tid));
  const int lane = tid & 63, w = tid >> 6, r = lane & 31, hh = lane >> 5;
  const int tokl = 8 * w + (r >> 2), g = r & 3, head = kvh * 4 + g;
  const int q0 = m * 64, t = q0 + tokl;
  const size_t tokg = (size_t)b * SEQ + t;
  float* imp = (float*)(smem + NSA_IMP_OFF);
  unsigned* selw = (unsigned*)(smem + NSA_SEL_OFF);
  for (int i = tid; i < 64 * 128; i += NTHR) imp[i] = 0.f;
  bf16x8 qf[4];
#pragma unroll
  for (int ds = 0; ds < 4; ++ds) {
    U8 q;
    q.u = *(const uint4*)(PJ + tokg * PP + C_NQ + head * 64 + ds * 16 + hh * 8);
    qf[ds] = q.v;
  }
  float gate[3];
#pragma unroll
  for (int br = 0; br < 3; ++br) gate[br] = sigmoidf_(bf2f(PJ[tokg * PP + C_NG + head * 3 + br]));
  f32x16 o[2];
  float* ofl = (float*)(smem + NSA_OFIN_OFF) + tid;
#pragma unroll
  for (int dt = 0; dt < 2; ++dt)
#pragma unroll
    for (int i = 0; i < 16; ++i) o[dt][i] = 0.f;
  unsigned long long sel_lo = 0ull, sel_hi = 0ull;
  const int imax = (t - 31) >> 4;
  {
    const int nct = ((4 * m + 2) >> 6) + 1;
    const u16* kc = (const u16*)(ws + WS_KC) + (size_t)(b * 2 + kvh) * 512 * 64;
    const u16* vct = (const u16*)(ws + WS_VCT) + (size_t)(b * 2 + kvh) * 64 * 512;
    float mrun = -1e30f, lrun = 0.f;
    nsa_segment<0>(kc, 64 * 64, 64, vct, 64, 512, nct, qf, o, mrun, lrun, m, tokl, imax, sel_lo, sel_hi, 0.f, 0.f, tokl, g, 0);
    float ltot = lrun + __shfl_xor(lrun, 32);
    float cinvl = ltot > 0.f ? 1.f / ltot : 0.f;
    float dm = 0.f, dl = 0.f;
    nsa_segment<1>(kc, 64 * 64, 64, vct, 64, 512, nct, qf, o, dm, dl, m, tokl, imax, sel_lo, sel_hi, mrun, cinvl, tokl, g, 0);
#pragma unroll
    for (int dt = 0; dt < 2; ++dt)
#pragma unroll
      for (int i = 0; i < 16; ++i) { ofl[(dt * 16 + i) * NTHR] = o[dt][i] * gate[0]; o[dt][i] = 0.f; }
  }
  __syncthreads();
  if (m < 16) {
    sel_lo = (1ull << (m + 1)) - 1ull;
  } else {
    {
      const int tk = lane >> 3, sub = lane & 7;
      const int tl2 = 8 * w + tk;
      unsigned key[16];
#pragma unroll
      for (int i = 0; i < 16; ++i) {
        const int j = sub + 8 * i;
        unsigned kv = (__float_as_uint(imp[tl2 * 128 + j]) & 0xFFFFFF80u) | (unsigned)(127 - j);
        key[i] = (j >= 1 && j <= m - 2) ? kv : 0u;
      }
      unsigned tau = 0u;
      for (int bit = 30; bit >= 0; --bit) {
        const unsigned cand = tau | (1u << bit);
        int cnt = 0;
#pragma unroll
        for (int i = 0; i < 16; ++i) cnt += (key[i] >= cand) ? 1 : 0;
        cnt += __builtin_amdgcn_mov_dpp(cnt, 0xB1, 0xF, 0xF, true);
        cnt += __builtin_amdgcn_mov_dpp(cnt, 0x4E, 0xF, 0xF, true);
        cnt += __builtin_amdgcn_mov_dpp(cnt, 0x141, 0xF, 0xF, true);
        if (cnt >= 13) tau = cand;
      }
      unsigned wsel[4] = {0u, 0u, 0u, 0u};
#pragma unroll
      for (int i = 0; i < 16; ++i)
        if (key[i] >= tau && key[i] != 0u) wsel[i >> 2] |= 1u << (8 * (i & 3) + sub);
#pragma unroll
      for (int q = 0; q < 4; ++q) {
        unsigned v = wsel[q];
        v |= (unsigned)__builtin_amdgcn_mov_dpp((int)v, 0xB1, 0xF, 0xF, true);
        v |= (unsigned)__builtin_amdgcn_mov_dpp((int)v, 0x4E, 0xF, 0xF, true);
        v |= (unsigned)__builtin_amdgcn_mov_dpp((int)v, 0x141, 0xF, 0xF, true);
        wsel[q] = v;
      }
      wsel[0] |= 1u;
      {
        const int f1 = m, f2 = m - 1;
#pragma unroll
        for (int q = 0; q < 4; ++q) {
          if ((f1 >> 5) == q) wsel[q] |= 1u << (f1 & 31);
          if ((f2 >> 5) == q) wsel[q] |= 1u << (f2 & 31);
        }
      }
      if (sub == 0) {
        selw[tl2 * 4 + 0] = wsel[0];
        selw[tl2 * 4 + 1] = wsel[1];
        selw[tl2 * 4 + 2] = wsel[2];
        selw[tl2 * 4 + 3] = wsel[3];
      }
    }
    __syncthreads();
    sel_lo = (unsigned long long)selw[tokl * 4 + 0] | ((unsigned long long)selw[tokl * 4 + 1] << 32);
    sel_hi = (unsigned long long)selw[tokl * 4 + 2] | ((unsigned long long)selw[tokl * 4 + 3] << 32);
  }
  {
    const u16* kp = PJ + (size_t)b * SEQ * PP + C_KS + kvh * 64;
    const u16* vp = (const u16*)(ws + WS_VST) + (size_t)(b * 2 + kvh) * 64 * SEQ;
    float mrun = -1e30f, lrun = 0.f;
    nsa_segment<2>(kp, (size_t)64 * PP, PP, vp, 64, SEQ, m + 1, qf, o, mrun, lrun, m, tokl, imax, sel_lo, sel_hi, 0.f, 0.f, tokl, g, 0);
    float ltot = lrun + __shfl_xor(lrun, 32);
    float sc = gate[1] / ltot;
#pragma unroll
    for (int dt = 0; dt < 2; ++dt)
#pragma unroll
      for (int i = 0; i < 16; ++i) { ofl[(dt * 16 + i) * NTHR] += o[dt][i] * sc; o[dt][i] = 0.f; }
  }
  {
    const int kb0 = m >= 8 ? m - 8 : 0;
    const u16* kp = PJ + ((size_t)b * SEQ + (size_t)kb0 * 64) * PP + C_KW + kvh * 64;
    const u16* vp = (const u16*)(ws + WS_VWT) + (size_t)(b * 2 + kvh) * 64 * SEQ + (size_t)kb0 * 64;
    float mrun = -1e30f, lrun = 0.f;
    nsa_segment<3>(kp, (size_t)64 * PP, PP, vp, 64, SEQ, m - kb0 + 1, qf, o, mrun, lrun, m, tokl, imax, sel_lo, sel_hi, 0.f, 0.f, tokl, g, kb0);
    float ltot = lrun + __shfl_xor(lrun, 32);
    float sc = gate[2] / ltot;
#pragma unroll
    for (int dt = 0; dt < 2; ++dt)
#pragma unroll
      for (int i = 0; i < 16; ++i) o[dt][i] = ofl[(dt * 16 + i) * NTHR] + o[dt][i] * sc;
  }
#pragma unroll
  for (int dt = 0; dt < 2; ++dt)
#pragma unroll
    for (int q4 = 0; q4 < 4; ++q4) {
      int d0 = dt * 32 + 8 * q4 + 4 * hh;
      uint2 zz = *(const uint2*)(PJ + tokg * PP + C_NZ + head * 64 + d0);
      float z0 = bf2f((u16)(zz.x & 0xFFFF)), z1 = bf2f((u16)(zz.x >> 16)), z2 = bf2f((u16)(zz.y & 0xFFFF)),
            z3 = bf2f((u16)(zz.y >> 16));
      uint2 ov;
      ov.x = pk2(o[dt][4 * q4 + 0] * siluf_(z0), o[dt][4 * q4 + 1] * siluf_(z1));
      ov.y = pk2(o[dt][4 * q4 + 2] * siluf_(z2), o[dt][4 * q4 + 3] * siluf_(z3));
      *(uint2*)(MIX + tokg * 1024 + 512 + head * 64 + d0) = ov;
    }
  __syncthreads();
}

__device__ __forceinline__ void phase4_nsa(const Params& p) {
  for (int wk = blockIdx.x; wk < 256; wk += gridDim.x) {
    int bk = wk >> 6, i = wk & 63;
#pragma unroll 1
    for (int rep = 0; rep < 2; ++rep) nsa_item(p, bk >> 1, bk & 1, rep ? i : 127 - i);
  }
}

__device__ __forceinline__ void phase6_res(const Params& p) {
  unsigned char* ws = p.ws;
  const uint2* MX = (const uint2*)(ws + WS_PROJ);
  const float* SS = (const float*)(ws + WS_SS1);
  u16* HB = (u16*)(ws + WS_XN);
  const size_t gtid = (size_t)blockIdx.x * NTHR + threadIdx.x, gn = (size_t)gridDim.x * NTHR;
  for (size_t i = gtid; i < (size_t)MTOK * 256; i += gn) {
    int row = (int)(i >> 8), c4 = (int)(i & 255);
    float rstd = rsqrtf(SS[row] * (1.f / 1024.f) + EPSV);
    uint2 mb = MX[i];
    float4 xv = ((const float4*)p.x)[i], gv = ((const float4*)p.post_norm)[c4];
    float4 hv;
    hv.x = xv.x + bf2f((u16)(mb.x & 0xFFFF)) * rstd * gv.x;
    hv.y = xv.y + bf2f((u16)(mb.x >> 16)) * rstd * gv.y;
    hv.z = xv.z + bf2f((u16)(mb.y & 0xFFFF)) * rstd * gv.z;
    hv.w = xv.w + bf2f((u16)(mb.y >> 16)) * rstd * gv.w;
    uint2 o;
    o.x = pk2(hv.x, hv.y);
    o.y = pk2(hv.z, hv.w);
    *(uint2*)(HB + i * 4) = o;
  }
}
__device__ __forceinline__ void phase8_out(const Params& p) {
  unsigned char* ws = p.ws;
  const uint2* HB = (const uint2*)(ws + WS_XN);
  const uint2* E = (const uint2*)(ws + WS_PROJ + (size_t)MTOK * 1024 * 2);
  const float* SS2 = (const float*)(ws + WS_SS2);
  const size_t gtid = (size_t)blockIdx.x * NTHR + threadIdx.x, gn = (size_t)gridDim.x * NTHR;
  for (size_t i = gtid; i < (size_t)MTOK * 256; i += gn) {
    int row = (int)(i >> 8), c4 = (int)(i & 255);
    float r2 = rsqrtf(SS2[row] * (1.f / 1024.f) + EPSV);
    uint2 hb = HB[i], eb = E[i];
    float4 g2 = ((const float4*)p.ple_norm)[c4];
    float4 hv;
    hv.x = bf2f((u16)(hb.x & 0xFFFF)) + bf2f((u16)(eb.x & 0xFFFF)) * r2 * g2.x;
    hv.y = bf2f((u16)(hb.x >> 16)) + bf2f((u16)(eb.x >> 16)) * r2 * g2.y;
    hv.z = bf2f((u16)(hb.y & 0xFFFF)) + bf2f((u16)(eb.y & 0xFFFF)) * r2 * g2.z;
    hv.w = bf2f((u16)(hb.y >> 16)) + bf2f((u16)(eb.y >> 16)) * r2 * g2.w;
    ((float4*)p.out)[i] = hv;
  }
}

#define XB_TMO 128
#define XB_XCNT(j) (256 + 64 * (j))
#define XB_XSUB(j) (1280 + 64 * (j))
#define XB_XGEN(j) (2304 + 64 * (j))
#define XB_TOP 3328
#define XB_TOPGEN 3392
#define XCD_BAR_WORDS 3456
#define XB_SPIN_CAP (1u << 18)
#define LAS __attribute__((address_space(3)))
__device__ __forceinline__ unsigned xb_ld(unsigned* p) { return __hip_atomic_load(p, __ATOMIC_RELAXED, __HIP_MEMORY_SCOPE_AGENT); }
__device__ __forceinline__ unsigned xb_add(unsigned* p, unsigned v) { return __hip_atomic_fetch_add(p, v, __ATOMIC_RELAXED, __HIP_MEMORY_SCOPE_AGENT); }
__device__ __forceinline__ unsigned xb_xcc_id() { return (unsigned)__builtin_amdgcn_s_getreg((3 << 11) | 20) & 0xFu; }
#define XB_SPIN(cond, bar)                                            \
  do {                                                                \
    unsigned _sp = 0;                                                 \
    while (cond) {                                                    \
      __builtin_amdgcn_s_sleep(1);                                    \
      if ((++_sp & 255u) == 0u) {                                     \
        if (xb_ld(&(bar)[XB_TMO])) break;                             \
        if (_sp > XB_SPIN_CAP) { atomicAdd(&(bar)[XB_TMO], 1u); break; } \
      }                                                               \
    }                                                                 \
  } while (0)
struct XcdBarrier {
  unsigned* bar;
  unsigned x;
  volatile LAS unsigned* st;
};
__device__ __forceinline__ XcdBarrier xcd_barrier_post(unsigned* bar, volatile LAS unsigned* st) {
  XcdBarrier b;
  b.bar = bar;
  b.x = xb_xcc_id();
  b.st = st;
  if (threadIdx.x == 0) (void)xb_add(&bar[XB_XCNT(b.x)], 1u);
  return b;
}
__device__ __forceinline__ void xcd_barrier_complete(unsigned* bar, unsigned x, unsigned& nloc, unsigned& nx) {
  const unsigned G = gridDim.x * gridDim.y * gridDim.z;
  unsigned sum, cnt, mine, sp = 0u;
  for (;;) {
    sum = 0u; cnt = 0u; mine = 0u;
#pragma unroll
    for (unsigned j = 0; j < 16; ++j) {
      const unsigned c = xb_ld(&bar[XB_XCNT(j)]);
      sum += c;
      cnt += (c > 0u) ? 1u : 0u;
      mine = (j == x) ? c : mine;
    }
    if (sum == G) break;
    __builtin_amdgcn_s_sleep(1);
    if ((++sp & 255u) == 0u) {
      if (xb_ld(&bar[XB_TMO])) break;
      if (sp > XB_SPIN_CAP) { atomicAdd(&bar[XB_TMO], 1u); break; }
    }
  }
  nloc = mine > 0u ? mine : 1u;
  nx = cnt > 0u ? cnt : 1u;
}
__device__ __forceinline__ void xcd_barrier(const XcdBarrier& b) {
  asm volatile("s_waitcnt vmcnt(0)" ::: "memory");
  __syncthreads();
  if (threadIdx.x == 0) {
    unsigned* bar = b.bar;
    __builtin_amdgcn_s_waitcnt(0);
    unsigned nloc = b.st[0], nx = b.st[1];
    if (nloc == 0u) {
      xcd_barrier_complete(bar, b.x, nloc, nx);
      b.st[0] = nloc;
      b.st[1] = nx;
    }
    const unsigned old = xb_add(&bar[XB_XSUB(b.x)], 1u);
    const unsigned gen = old / nloc;
    if (old + 1u == (gen + 1u) * nloc) {
      __builtin_amdgcn_fence(__ATOMIC_RELEASE, "agent");
      asm volatile("s_waitcnt vmcnt(0)" ::: "memory");
      const unsigned og = xb_add(&bar[XB_TOP], 1u);
      const unsigned tg = og / nx;
      if (og + 1u == (tg + 1u) * nx) xb_add(&bar[XB_TOPGEN], 1u);
      else XB_SPIN(xb_ld(&bar[XB_TOPGEN]) == tg, bar);
      __builtin_amdgcn_fence(__ATOMIC_ACQUIRE, "agent");
      xb_add(&bar[XB_XGEN(b.x)], 1u);
      asm volatile("s_waitcnt vmcnt(0)" ::: "memory");
    } else {
      XB_SPIN(xb_ld(&bar[XB_XGEN(b.x)]) == gen, bar);
      __builtin_amdgcn_fence(__ATOMIC_ACQUIRE, "agent");
      asm volatile("s_waitcnt vmcnt(0)" ::: "memory");
    }
  }
  __syncthreads();
}

#define NPHASE 9
#if !FUSED
__device__ __forceinline__ void run_phase(const Params& p, int ph) {
#ifdef ONLY_PHASE
  ph = ONLY_PHASE;
#endif
  switch (ph) {
    case 0: phase_prep(p); break;
    case 1: gemm_phase<0>(p); break;
    case 2: phase2_rope(p); phase2_vtrans(p); phase2_compress(p); phase2_gla1(p); break;
    case 3: phase3_scan(p); break;
    case 4: phase4_nsa(p); phase4_gla3(p); break;
    case 5: gemm_phase<1>(p); break;
    case 6: phase6_res(p); break;
    case 7: gemm_phase<2>(p); break;
    default: phase8_out(p); break;
  }
}
#endif

#ifndef DUP
#define DUP -1
#endif
constexpr int LDS_BYTES = 139264;
constexpr int LDS_BAR_OFF = LDS_BYTES - 16;
#define GSYNC() xcd_barrier(xb)
__global__ void __launch_bounds__(NTHR) mega_kernel(Params p) {
  cg::grid_group grid = cg::this_grid();
  volatile LAS unsigned* st = (volatile LAS unsigned*)(smem + LDS_BAR_OFF);
  if (threadIdx.x == 0) { st[0] = 0u; st[1] = 0u; }
  __syncthreads();
  XcdBarrier xb = xcd_barrier_post((unsigned*)(p.ws + WS_BAR), st);
  phase_prep(p);
  if (gridDim.x == 0x7FFFFFFFu) grid.sync();
  GSYNC();
  if (DUP == 0) { phase_prep(p); GSYNC(); }
  gemm_phase<0>(p);
  GSYNC();
  if (DUP == 1) { gemm_phase<0>(p); GSYNC(); }
  if (DUP == 20) { phase2_vtrans(p); GSYNC(); }
  if (DUP == 21) { phase2_compress(p); GSYNC(); }
  if (DUP == 22) { phase2_gla1(p); GSYNC(); }
  phase2_rope(p);
  phase2_vtrans(p);
#pragma unroll 1
  for (int st = 0; st < 2; ++st) {
    if ((st ^ (int)(blockIdx.x & 1)) == 0) phase2_compress(p);
    else phase2_gla1(p);
  }
  GSYNC();
  phase3_scan(p);
  GSYNC();
  if (DUP == 40) { phase4_nsa(p); GSYNC(); }
  if (DUP == 41) { phase4_gla3(p); GSYNC(); }
#pragma unroll 1
  for (int st = 0; st < 2; ++st) {
    if ((st ^ (int)(blockIdx.x & 1)) == 0) phase4_nsa(p);
    else phase4_gla3(p);
  }
  GSYNC();
  gemm_phase<1>(p);
  GSYNC();
  if (DUP == 6) { phase6_res(p); GSYNC(); }
  gemm_phase<2>(p);
  return;
  GSYNC();
  if (DUP == 99) { for (int i = 0; i < 8; ++i) GSYNC(); }
  if (DUP == 8) { phase8_out(p); GSYNC(); }
  phase8_out(p);
}
#if !FUSED
__global__ void __launch_bounds__(NTHR) phase_kernel(Params p, int ph) { run_phase(p, ph); }
#endif


extern "C" void kernel_launch(void* const* d_in, const int* in_sizes, int n_in, void* d_out, int out_size, void* d_ws,
                              size_t ws_size, hipStream_t stream) {
  static int grid_blocks = 0;
  if (!grid_blocks) {
    int dev = 0, cus = 0, per_cu = 0;
    hipGetDevice(&dev);
    hipDeviceGetAttribute(&cus, hipDeviceAttributeMultiprocessorCount, dev);
    hipFuncSetAttribute((const void*)mega_kernel, hipFuncAttributeMaxDynamicSharedMemorySize, LDS_BYTES);
#if !FUSED
    hipFuncSetAttribute((const void*)phase_kernel, hipFuncAttributeMaxDynamicSharedMemorySize, LDS_BYTES);
#endif
    hipOccupancyMaxActiveBlocksPerMultiprocessor(&per_cu, (const void*)mega_kernel, NTHR, LDS_BYTES);
    if (per_cu < 1) {
      fprintf(stderr, "occupancy query returned %d\n", per_cu);
      per_cu = 1;
    }
    if (per_cu > 1) per_cu = 1;
    grid_blocks = cus * per_cu;
    if (ws_size < WS_END2) fprintf(stderr, "workspace too small: %zu < %zu\n", ws_size, (size_t)WS_END2);
  }
  Params p{};
  p.x = (const float*)d_in[0];
  p.p = (const float*)d_in[1];
  p.pre_norm = (const float*)d_in[2];
  p.w_in = (const float*)d_in[3];
  p.a_up = (const float*)d_in[4];
  p.a_bias = (const float*)d_in[5];
  p.gnorm = (const float*)d_in[6];
  p.pos_k = (const float*)d_in[7];
  p.w1k = (const float*)d_in[8];
  p.w2k = (const float*)d_in[9];
  p.pos_v = (const float*)d_in[10];
  p.w1v = (const float*)d_in[11];
  p.w2v = (const float*)d_in[12];
  p.w_out = (const float*)d_in[13];
  p.post_norm = (const float*)d_in[14];
  p.ple_proj = (const float*)d_in[15];
  p.ple_gate = (const float*)d_in[16];
  p.ple_norm = (const float*)d_in[17];
  p.out = (float*)d_out;
  p.ws = (unsigned char*)d_ws;
#if FUSED
  hipMemsetAsync((char*)d_ws + WS_BAR, 0, 16384, stream);
  void* args[] = {&p};
  hipError_t e = hipLaunchCooperativeKernel((const void*)mega_kernel, dim3(grid_blocks), dim3(NTHR), args, LDS_BYTES, stream);
  if (e != hipSuccess) fprintf(stderr, "cooperative launch failed: %s (grid %d)\n", hipGetErrorString(e), grid_blocks);
#else
  for (int ph = 0; ph < NPHASE; ++ph) hipLaunchKernelGGL(phase_kernel, dim3(grid_blocks), dim3(NTHR), LDS_BYTES, stream, p, ph);
#endif
}
```

```cpp
#include <hip/hip_runtime.h>
#include <hip/hip_bf16.h>
#include <hip/hip_cooperative_groups.h>
#include <cstdio>
namespace cg = cooperative_groups;

#ifndef FUSED
#define FUSED 1
#endif

typedef unsigned short u16;
using bf16x8 = __attribute__((ext_vector_type(8))) short;
using f32x4 = __attribute__((ext_vector_type(4))) float;
using f32x16 = __attribute__((ext_vector_type(16))) float;
typedef __bf16 bf2_t __attribute__((ext_vector_type(2)));
typedef float f2_t __attribute__((ext_vector_type(2)));

#define NTHR 512
#define SEQ 8192
#define MTOK 16384
#define PP 3368
#define C_GQ 0
#define C_GK 256
#define C_GV 512
#define C_GA 1024
#define C_GZ 1040
#define C_NQ 1552
#define C_KC 2064
#define C_VC 2192
#define C_KS 2320
#define C_VS 2448
#define C_KW 2576
#define C_VW 2704
#define C_NG 2832
#define C_NZ 2856
#define EPSV 1e-6f
#define QSCALE_L2 0.18033688011112042f

constexpr size_t WS_XN = 0;
constexpr size_t WS_WTIN = WS_XN + (size_t)MTOK * 1024 * 2;
constexpr size_t WS_WTOUT = WS_WTIN + (size_t)3584 * 1024 * 2;
constexpr size_t WS_WTG = WS_WTOUT + (size_t)1024 * 1024 * 2;
constexpr size_t WS_WTP = WS_WTG + (size_t)1024 * 1024 * 2;
constexpr size_t WS_W1K = WS_WTP + (size_t)1024 * 256 * 2;
constexpr size_t WS_W1V = WS_W1K + (size_t)128 * 2048 * 2;
constexpr size_t WS_W2K = WS_W1V + (size_t)128 * 2048 * 2;
constexpr size_t WS_W2V = WS_W2K + (size_t)64 * 128 * 2;
constexpr size_t WS_PB = WS_W2V + (size_t)64 * 128 * 2;
constexpr size_t WS_ROPEC = WS_PB + (size_t)MTOK * 256 * 2;
constexpr size_t WS_ROPES = WS_ROPEC + (size_t)SEQ * 8 * 4;
constexpr size_t WS_SS1 = WS_ROPES + (size_t)SEQ * 8 * 4;
constexpr size_t WS_SS2 = WS_SS1 + (size_t)MTOK * 4;
constexpr size_t WS_PROJ = WS_SS2 + (size_t)MTOK * 4;
constexpr size_t WS_BCUM = WS_PROJ + (size_t)MTOK * PP * 2;
constexpr size_t WS_DS = WS_BCUM + (size_t)MTOK * 256 * 4;
constexpr size_t WS_DEC = WS_DS + (size_t)1024 * 8192 * 4;
constexpr size_t WS_KC = WS_DEC + (size_t)1024 * 64 * 4;
constexpr size_t WS_VCT = WS_KC + (size_t)4 * 512 * 64 * 2;
constexpr size_t WS_VST = WS_VCT + (size_t)4 * 512 * 64 * 2;
constexpr size_t WS_VWT = WS_VST + (size_t)4 * 64 * SEQ * 2;
constexpr size_t WS_BAR = WS_VWT + (size_t)4 * 64 * SEQ * 2;
constexpr size_t WS_END = WS_BAR + 16384;
constexpr size_t WS_E1 = WS_END;
constexpr size_t WS_END2 = WS_E1 + (size_t)MTOK * 1024 * 2;

struct Params {
  const float *x, *p, *pre_norm, *w_in, *a_up, *a_bias, *gnorm, *pos_k, *w1k, *w2k, *pos_v, *w1v, *w2v, *w_out, *post_norm,
      *ple_proj, *ple_gate, *ple_norm;
  float* out;
  unsigned char* ws;
};

extern __shared__ __attribute__((aligned(16))) unsigned char smem[];

__device__ __forceinline__ float bf2f(u16 h) { return __uint_as_float(((unsigned)h) << 16); }
__device__ __forceinline__ unsigned pk2(float a, float b) {
  f2_t v = {a, b};
  bf2_t r = __builtin_convertvector(v, bf2_t);
  return *(unsigned*)&r;
}
__device__ __forceinline__ u16 f2bf(float a) { return (u16)(pk2(a, 0.f) & 0xFFFFu); }
__device__ __forceinline__ float wave_sum(float v) {
  for (int o = 32; o > 0; o >>= 1) v += __shfl_xor(v, o);
  return v;
}
__device__ __forceinline__ float sigmoidf_(float x) { return __builtin_amdgcn_rcpf(1.f + __expf(-x)); }
__device__ __forceinline__ float siluf_(float x) { return x * __builtin_amdgcn_rcpf(1.f + __expf(-x)); }
__device__ __forceinline__ float ex2(float x) { return __builtin_amdgcn_exp2f(x); }
__device__ __forceinline__ float quad_sum(float v) {
  v += __int_as_float(__builtin_amdgcn_mov_dpp(__float_as_int(v), 0xB1, 0xF, 0xF, true));
  v += __int_as_float(__builtin_amdgcn_mov_dpp(__float_as_int(v), 0x4E, 0xF, 0xF, true));
  return v;
}
__device__ __forceinline__ f32x16 mfma32(bf16x8 a, bf16x8 b, f32x16 c) {
  return __builtin_amdgcn_mfma_f32_32x32x16_bf16(a, b, c, 0, 0, 0);
}
union U8 {
  bf16x8 v;
  uint4 u;
  uint2 h[2];
  u16 s[8];
};

constexpr int G_BK = 64, G_HALF = 128, G_HT = G_HALF * G_BK;
__device__ __forceinline__ int lds_byte(int r, int c) {
  int st = (r >> 4) * 2 + (c >> 5), rr = r & 15, cc = c & 31, ob = rr * 64 + cc * 2;
  return st * 1024 + (ob ^ (((ob >> 9) & 1) << 5));
}
__device__ __forceinline__ void stage_rc(int b, int& R, int& C) {
  int st = b / 1024, sb = b % 1024, swz = sb ^ (((sb >> 9) & 1) << 5);
  R = (st >> 1) * 16 + swz / 64;
  C = (st & 1) * 32 + (swz % 64) / 2;
}

template <int K, bool SWAP = false>
__device__ __forceinline__ void gemm256(const u16* __restrict__ A, const u16* __restrict__ Bt, const int brow,
                                        const int bcol, f32x4 (&acc)[2][2][4][2]) {
  u16* shm = (u16*)smem;
#define SA(b, h) (shm + ((b)*2 + (h)) * G_HT)
#define SB(b, h) (shm + (4 + (b)*2 + (h)) * G_HT)
#define STAGE(P, BASE, br, kt)                                                                                       \
  do {                                                                                                               \
    long _g = (long)(br)*K + (long)(kt)*G_BK;                                                                        \
    for (int _i = 0; _i < 2; ++_i) {                                                                                 \
      int _b = tidx * 16 + _i * 8192;                                                                                \
      int _r, _c;                                                                                                    \
      stage_rc(_b, _r, _c);                                                                                          \
      __builtin_amdgcn_global_load_lds((const unsigned*)(BASE + _g + (long)_r * K + _c), (unsigned*)((char*)(P) + _b), \
                                       16, 0, 0);                                                                    \
    }                                                                                                                \
  } while (0)
#define LDA(dst, b, h)                                                                                               \
  for (int m = 0; m < 4; ++m)                                                                                        \
    for (int k = 0; k < 2; ++k)                                                                                      \
  dst[m][k] = *reinterpret_cast<const bf16x8*>((char*)SA(b, h) + lds_byte(wr * 64 + m * 16 + fr, k * 32 + fq * 8))
#define LDB(dst, b, h)                                                                                               \
  for (int n = 0; n < 2; ++n)                                                                                        \
    for (int k = 0; k < 2; ++k)                                                                                      \
  dst[n][k] = *reinterpret_cast<const bf16x8*>((char*)SB(b, h) + lds_byte(wc * 32 + n * 16 + fr, k * 32 + fq * 8))
#define MMA(ai, bj, At, Bt_)                                                                                         \
  do {                                                                                                               \
    __builtin_amdgcn_s_setprio(1);                                                                                   \
    for (int m = 0; m < 4; ++m)                                                                                      \
      for (int n = 0; n < 2; ++n)                                                                                    \
        for (int k = 0; k < 2; ++k)                                                                                  \
          acc[ai][bj][m][n] = SWAP ? __builtin_amdgcn_mfma_f32_16x16x32_bf16(Bt_[n][k], At[m][k], acc[ai][bj][m][n], 0, 0, 0) \
                                   : __builtin_amdgcn_mfma_f32_16x16x32_bf16(At[m][k], Bt_[n][k], acc[ai][bj][m][n], 0, 0, 0); \
    __builtin_amdgcn_s_setprio(0);                                                                                   \
  } while (0)
#define WAIT_V(n) asm volatile("s_waitcnt vmcnt(" #n ")" ::: "memory")
#define WAIT_L(n) asm volatile("s_waitcnt lgkmcnt(" #n ")" ::: "memory")
#define BAR __builtin_amdgcn_s_barrier()
#define SCHED __builtin_amdgcn_sched_barrier(0)
  int tidx = threadIdx.x;
  asm volatile("" : "+v"(tidx));
  const int wid = tidx >> 6, lane = tidx & 63, wr = wid >> 2, wc = wid & 3, fr = lane & 15, fq = lane >> 4;
#pragma unroll
  for (int a = 0; a < 2; ++a)
#pragma unroll
    for (int b = 0; b < 2; ++b)
#pragma unroll
      for (int m = 0; m < 4; ++m)
#pragma unroll
        for (int n = 0; n < 2; ++n) acc[a][b][m][n] = f32x4{0.f, 0.f, 0.f, 0.f};
  bf16x8 At[4][2], B0[2][2], B1[2][2];
  const int nt = K / G_BK;
  STAGE(SB(0, 0), Bt, bcol, 0);
  STAGE(SA(0, 0), A, brow, 0);
  STAGE(SB(0, 1), Bt, bcol + G_HALF, 0);
  STAGE(SA(0, 1), A, brow + G_HALF, 0);
  if (wr == 1) BAR;
  WAIT_V(4);
  BAR;
  STAGE(SB(1, 0), Bt, bcol, 1);
  STAGE(SA(1, 0), A, brow, 1);
  STAGE(SB(1, 1), Bt, bcol + G_HALF, 1);
  WAIT_V(6);
  BAR;
  for (int t = 0; t < nt - 2; t += 2) {
    LDB(B0, 0, 0); SCHED; LDA(At, 0, 0); STAGE(SA(1, 1), A, brow + G_HALF, t + 1);
    WAIT_L(8); BAR; WAIT_L(0); MMA(0, 0, At, B0); BAR; SCHED;
    LDB(B1, 0, 1); STAGE(SB(0, 0), Bt, bcol, t + 2);
    BAR; WAIT_L(0); MMA(0, 1, At, B1); BAR;
    LDA(At, 0, 1); STAGE(SA(0, 0), A, brow, t + 2);
    BAR; WAIT_L(0); MMA(1, 0, At, B0); BAR; SCHED;
    STAGE(SB(0, 1), Bt, bcol + G_HALF, t + 2);
    WAIT_V(6); BAR; MMA(1, 1, At, B1); BAR;
    LDB(B0, 1, 0); SCHED; LDA(At, 1, 0); STAGE(SA(0, 1), A, brow + G_HALF, t + 2);
    WAIT_L(8); BAR; WAIT_L(0); MMA(0, 0, At, B0); BAR; SCHED;
    LDB(B1, 1, 1); STAGE(SB(1, 0), Bt, bcol, t + 3);
    BAR; WAIT_L(0); MMA(0, 1, At, B1); BAR;
    LDA(At, 1, 1); STAGE(SA(1, 0), A, brow, t + 3);
    BAR; WAIT_L(0); MMA(1, 0, At, B0); BAR; SCHED;
    STAGE(SB(1, 1), Bt, bcol + G_HALF, t + 3);
    WAIT_V(6); BAR; MMA(1, 1, At, B1); BAR;
  }
  {
    LDB(B0, 0, 0); LDA(At, 0, 0); STAGE(SA(1, 1), A, brow + G_HALF, nt - 1);
    BAR; WAIT_L(0); MMA(0, 0, At, B0); BAR;
    LDB(B1, 0, 1); BAR; WAIT_L(0); MMA(0, 1, At, B1); BAR;
    LDA(At, 0, 1); WAIT_V(4); BAR; WAIT_L(0); MMA(1, 0, At, B0); MMA(1, 1, At, B1); BAR;
  }
  {
    LDB(B0, 1, 0); LDA(At, 1, 0); WAIT_V(2); BAR; WAIT_L(0); MMA(0, 0, At, B0); BAR;
    LDB(B1, 1, 1); WAIT_V(0); BAR; WAIT_L(0); MMA(0, 1, At, B1); BAR;
    LDA(At, 1, 1); BAR; WAIT_L(0); MMA(1, 0, At, B0); MMA(1, 1, At, B1); BAR;
  }
  if (wr == 0) BAR;
#undef SA
#undef SB
#undef STAGE
#undef LDA
#undef LDB
#undef MMA
}

__device__ __forceinline__ void tile_map(int wgid, int nM, int nN, int& pm, int& pn) {
  const int NX = 8, WGM = 8;
  int nwg = nM * nN;
  {
    int q = nwg / NX, r = nwg % NX, xcd = wgid % NX, off = wgid / NX;
    wgid = (xcd < r ? xcd * (q + 1) : r * (q + 1) + (xcd - r) * q) + off;
  }
  int nig = WGM * nN, gid = wgid / nig, fm = gid * WGM, gsz = min(nM - fm, WGM);
  pm = fm + ((wgid % nig) % gsz);
  pn = (wgid % nig) / gsz;
}

__device__ __forceinline__ void e1_tile(unsigned char* ws, int t2, f32x4 (&acc)[2][2][4][2]) {
  int pm, pn;
  tile_map(t2, 64, 4, pm, pn);
  const int brow = pm * 256, bcol = pn * 256;
  gemm256<256, true>((const u16*)(ws + WS_PB), (const u16*)(ws + WS_WTP), brow, bcol, acc);
  int tide = threadIdx.x;
  asm volatile("" : "+v"(tide));
  const int wid = tide >> 6, lane = tide & 63, wr = wid >> 2, wc = wid & 3, fr = lane & 15, fq = lane >> 4;
  u16* E1 = (u16*)(ws + WS_E1);
#pragma unroll
  for (int ai = 0; ai < 2; ++ai)
#pragma unroll
    for (int m = 0; m < 4; ++m) {
      const int row = brow + ai * 128 + wr * 64 + m * 16 + fr;
#pragma unroll
      for (int bj = 0; bj < 2; ++bj)
#pragma unroll
        for (int n = 0; n < 2; ++n) {
          const int col0 = bcol + bj * 128 + wc * 32 + n * 16 + fq * 4;
          uint2 o;
          o.x = pk2(acc[ai][bj][m][n][0], acc[ai][bj][m][n][1]);
          o.y = pk2(acc[ai][bj][m][n][2], acc[ai][bj][m][n][3]);
          *(uint2*)(E1 + (size_t)row * 1024 + col0) = o;
        }
    }
  asm volatile("s_waitcnt vmcnt(0)" ::: "memory");
  __syncthreads();
}

template <int EPI>
__device__ __forceinline__ void gemm_phase(const Params& p) {
  unsigned char* ws = p.ws;
  const int nM = 64, nN = (EPI == 0) ? 14 : 4;
  f32x4 acc[2][2][4][2];
  for (int t = blockIdx.x; t < nM * nN; t += gridDim.x) {
    int tide = threadIdx.x;
    asm volatile("" : "+v"(tide));
    const int wid = tide >> 6, lane = tide & 63, wr = wid >> 2, wc = wid & 3, fr = lane & 15, fq = lane >> 4;
    int pm, pn;
    tile_map(t, nM, nN, pm, pn);
    const int brow = pm * 256, bcol = pn * 256;
    if (EPI == 0) {
      gemm256<1024>((const u16*)(ws + WS_XN), (const u16*)(ws + WS_WTIN), brow, bcol, acc);
      u16* PJ = (u16*)(ws + WS_PROJ);
#pragma unroll
      for (int ai = 0; ai < 2; ++ai)
#pragma unroll
        for (int bj = 0; bj < 2; ++bj)
#pragma unroll
          for (int m = 0; m < 4; ++m)
#pragma unroll
            for (int n = 0; n < 2; ++n) {
              int col = bcol + bj * 128 + wc * 32 + n * 16 + fr;
              if (col < PP) {
#pragma unroll
                for (int j = 0; j < 4; ++j) {
                  int row = brow + ai * 128 + wr * 64 + m * 16 + fq * 4 + j;
                  PJ[(size_t)row * PP + col] = f2bf(acc[ai][bj][m][n][j]);
                }
              }
            }
    } else if (EPI == 1) {
      gemm256<1024, true>((const u16*)(ws + WS_XN), (const u16*)(ws + WS_WTOUT), brow, bcol, acc);
      float* SS = (float*)(ws + WS_SS1);
#pragma unroll
      for (int ai = 0; ai < 2; ++ai)
#pragma unroll
        for (int m = 0; m < 4; ++m) {
          const int row = brow + ai * 128 + wr * 64 + m * 16 + fr;
          float ss = 0.f;
#pragma unroll
          for (int bj = 0; bj < 2; ++bj)
#pragma unroll
            for (int n = 0; n < 2; ++n)
#pragma unroll
              for (int j = 0; j < 4; ++j) ss += acc[ai][bj][m][n][j] * acc[ai][bj][m][n][j];
          ss += __shfl_xor(ss, 16);
          ss += __shfl_xor(ss, 32);
          if (fq == 0) atomicAdd(&SS[row], ss);
        }
      {
        unsigned* cnt = (unsigned*)(ws + WS_BAR) + 3584 + pm * 8 + 4;
        asm volatile("s_waitcnt vmcnt(0)" ::: "memory");
        __syncthreads();
        if (threadIdx.x == 0) {
          __builtin_amdgcn_fence(__ATOMIC_RELEASE, "agent");
          asm volatile("s_waitcnt vmcnt(0)" ::: "memory");
          __hip_atomic_fetch_add(cnt, 1u, __ATOMIC_RELAXED, __HIP_MEMORY_SCOPE_AGENT);
          unsigned sp = 0;
          while (__hip_atomic_load(cnt, __ATOMIC_RELAXED, __HIP_MEMORY_SCOPE_AGENT) < 4u) {
            __builtin_amdgcn_s_sleep(1);
            if (++sp > (1u << 22)) break;
          }
          __builtin_amdgcn_fence(__ATOMIC_ACQUIRE, "agent");
          asm volatile("s_waitcnt vmcnt(0)" ::: "memory");
        }
        __syncthreads();
        int tide4 = threadIdx.x;
        asm volatile("" : "+v"(tide4));
        const int wid4 = tide4 >> 6, lane4 = tide4 & 63, wr4 = wid4 >> 2, wc4 = wid4 & 3, fr4 = lane4 & 15, fq4 = lane4 >> 4;
        u16* HB = (u16*)(ws + WS_XN);
#pragma unroll
        for (int ai = 0; ai < 2; ++ai)
#pragma unroll
          for (int m = 0; m < 4; ++m) {
            const int row = brow + ai * 128 + wr4 * 64 + m * 16 + fr4;
            const float r1 = rsqrtf(__hip_atomic_load(&SS[row], __ATOMIC_RELAXED, __HIP_MEMORY_SCOPE_AGENT) * (1.f / 1024.f) + EPSV);
#pragma unroll
            for (int bj = 0; bj < 2; ++bj)
#pragma unroll
              for (int n = 0; n < 2; ++n) {
                const int col0 = bcol + bj * 128 + wc4 * 32 + n * 16 + fq4 * 4;
                const size_t idx = (size_t)row * 1024 + col0;
                const float4 xv = *(const float4*)(p.x + idx);
                const float4 gv = *(const float4*)(p.post_norm + col0);
                uint2 o;
                o.x = pk2(xv.x + acc[ai][bj][m][n][0] * r1 * gv.x, xv.y + acc[ai][bj][m][n][1] * r1 * gv.y);
                o.y = pk2(xv.z + acc[ai][bj][m][n][2] * r1 * gv.z, xv.w + acc[ai][bj][m][n][3] * r1 * gv.w);
                *(uint2*)(HB + idx) = o;
              }
            asm volatile("" ::: "memory");
          }
      }
    } else {
      const u16* E = (const u16*)(ws + WS_E1);
      float* SS = (float*)(ws + WS_SS2);
      gemm256<1024, true>((const u16*)(ws + WS_XN), (const u16*)(ws + WS_WTG), brow, bcol, acc);
      int tide2 = threadIdx.x;
      asm volatile("" : "+v"(tide2));
      const int wid2 = tide2 >> 6, lane2 = tide2 & 63, wr2 = wid2 >> 2, wc2 = wid2 & 3, fr2 = lane2 & 15, fq2 = lane2 >> 4;
#pragma unroll
      for (int ai = 0; ai < 2; ++ai)
#pragma unroll
        for (int m = 0; m < 4; ++m) {
          const int row = brow + ai * 128 + wr2 * 64 + m * 16 + fr2;
          float ss = 0.f;
#pragma unroll
          for (int bj = 0; bj < 2; ++bj)
#pragma unroll
            for (int n = 0; n < 2; ++n) {
              const int col0 = bcol + bj * 128 + wc2 * 32 + n * 16 + fq2 * 4;
              const uint2 eb = *(const uint2*)(E + (size_t)row * 1024 + col0);
              const float e0 = bf2f((u16)(eb.x & 0xFFFF)), e1 = bf2f((u16)(eb.x >> 16)), e2 = bf2f((u16)(eb.y & 0xFFFF)), e3 = bf2f((u16)(eb.y >> 16));
              const float v0 = e0 * sigmoidf_(acc[ai][bj][m][n][0]), v1 = e1 * sigmoidf_(acc[ai][bj][m][n][1]);
              const float v2 = e2 * sigmoidf_(acc[ai][bj][m][n][2]), v3 = e3 * sigmoidf_(acc[ai][bj][m][n][3]);
              acc[ai][bj][m][n][0] = v0; acc[ai][bj][m][n][1] = v1; acc[ai][bj][m][n][2] = v2; acc[ai][bj][m][n][3] = v3;
              ss += (v0 * v0 + v1 * v1) + (v2 * v2 + v3 * v3);
            }
          asm volatile("" ::: "memory");
          ss += __shfl_xor(ss, 16);
          ss += __shfl_xor(ss, 32);
          if (fq2 == 0) atomicAdd(&SS[row], ss);
        }
      {
        unsigned* cnt = (unsigned*)(ws + WS_BAR) + 3584 + pm * 8;
        asm volatile("s_waitcnt vmcnt(0)" ::: "memory");
        __syncthreads();
        if (threadIdx.x == 0) {
          __builtin_amdgcn_fence(__ATOMIC_RELEASE, "agent");
          asm volatile("s_waitcnt vmcnt(0)" ::: "memory");
          __hip_atomic_fetch_add(cnt, 1u, __ATOMIC_RELAXED, __HIP_MEMORY_SCOPE_AGENT);
          unsigned sp = 0;
          while (__hip_atomic_load(cnt, __ATOMIC_RELAXED, __HIP_MEMORY_SCOPE_AGENT) < 4u) {
            __builtin_amdgcn_s_sleep(1);
            if (++sp > (1u << 22)) break;
          }
          __builtin_amdgcn_fence(__ATOMIC_ACQUIRE, "agent");
          asm volatile("s_waitcnt vmcnt(0)" ::: "memory");
        }
        __syncthreads();
        int tide4 = threadIdx.x;
        asm volatile("" : "+v"(tide4));
        const int wid4 = tide4 >> 6, lane4 = tide4 & 63, wr4 = wid4 >> 2, wc4 = wid4 & 3, fr4 = lane4 & 15, fq4 = lane4 >> 4;
        const u16* HB = (const u16*)(ws + WS_XN);
#pragma unroll
        for (int ai = 0; ai < 2; ++ai)
#pragma unroll
          for (int m = 0; m < 4; ++m) {
            const int row = brow + ai * 128 + wr4 * 64 + m * 16 + fr4;
            const float r2 = rsqrtf(__hip_atomic_load(&SS[row], __ATOMIC_RELAXED, __HIP_MEMORY_SCOPE_AGENT) * (1.f / 1024.f) + EPSV);
#pragma unroll
            for (int bj = 0; bj < 2; ++bj)
#pragma unroll
              for (int n = 0; n < 2; ++n) {
                const int col0 = bcol + bj * 128 + wc4 * 32 + n * 16 + fq4 * 4;
                const size_t idx = (size_t)row * 1024 + col0;
                const uint2 hb = *(const uint2*)(HB + idx);
                const float4 gv = *(const float4*)(p.ple_norm + col0);
                float4 o;
                o.x = bf2f((u16)(hb.x & 0xFFFF)) + acc[ai][bj][m][n][0] * r2 * gv.x;
                o.y = bf2f((u16)(hb.x >> 16)) + acc[ai][bj][m][n][1] * r2 * gv.y;
                o.z = bf2f((u16)(hb.y & 0xFFFF)) + acc[ai][bj][m][n][2] * r2 * gv.z;
                o.w = bf2f((u16)(hb.y >> 16)) + acc[ai][bj][m][n][3] * r2 * gv.w;
                *(float4*)(p.out + idx) = o;
              }
            asm volatile("" ::: "memory");
          }
      }
    }
    asm volatile("s_waitcnt vmcnt(0)" ::: "memory");
    __syncthreads();
  }
  if (EPI == 0) {
    const int G = (int)gridDim.x, rem = (nM * nN) % G;
    const int first = rem, nE = G - rem;
    const int me = (int)blockIdx.x - first;
    if (me >= 0)
      for (int t2 = me; t2 < 256; t2 += nE) e1_tile(ws, t2, acc);
  }
}

__device__ __forceinline__ void transpose_tile(const float* __restrict__ src, int R, int C, u16* __restrict__ dst, int tr, int tc) {
  float* tile = (float*)smem;
  const int tid = threadIdx.x;
  const int r0 = tr * 64, c0 = tc * 64;
  {
    int cc = tid & 63, rr = tid >> 6;
#pragma unroll
    for (int i = 0; i < 8; ++i) {
      int r = rr + 8 * i;
      float v = 0.f;
      if (c0 + cc < C) v = src[(size_t)(r0 + r) * C + c0 + cc];
      tile[r * 65 + cc] = v;
    }
  }
  __syncthreads();
  {
    int rr = tid & 63, cc = tid >> 6;
#pragma unroll
    for (int i = 0; i < 8; ++i) {
      int c = cc + 8 * i;
      dst[(size_t)(c0 + c) * R + r0 + rr] = f2bf(tile[rr * 65 + c]);
    }
  }
  __syncthreads();
}

__device__ __forceinline__ void phase_prep(const Params& p) {
  unsigned char* ws = p.ws;
  const int tid = threadIdx.x, lane = tid & 63, wave = tid >> 6;
  const int nblk = gridDim.x, bid = blockIdx.x;
  const size_t gtid = (size_t)bid * NTHR + tid, gn = (size_t)nblk * NTHR;
  {
    u16* XN = (u16*)(ws + WS_XN);
    float4 g4[4];
#pragma unroll
    for (int i = 0; i < 4; ++i) g4[i] = ((const float4*)p.pre_norm)[lane + 64 * i];
    for (int row0 = (bid * 8 + wave) * 4; row0 < MTOK; row0 += nblk * 8 * 4) {
      float4 v[4][4];
      float ss[4];
#pragma unroll
      for (int q = 0; q < 4; ++q) {
        const float4* xr = (const float4*)(p.x + (size_t)(row0 + q) * 1024);
#pragma unroll
        for (int i = 0; i < 4; ++i) v[q][i] = xr[lane + 64 * i];
      }
#pragma unroll
      for (int q = 0; q < 4; ++q) {
        float s = 0.f;
#pragma unroll
        for (int i = 0; i < 4; ++i) s += v[q][i].x * v[q][i].x + v[q][i].y * v[q][i].y + v[q][i].z * v[q][i].z + v[q][i].w * v[q][i].w;
        ss[q] = s;
      }
#pragma unroll
      for (int o = 32; o > 0; o >>= 1) {
#pragma unroll
        for (int q = 0; q < 4; ++q) ss[q] += __shfl_xor(ss[q], o);
      }
#pragma unroll
      for (int q = 0; q < 4; ++q) {
        float r = rsqrtf(ss[q] * (1.f / 1024.f) + EPSV);
#pragma unroll
        for (int i = 0; i < 4; ++i) {
          uint2 o;
          o.x = pk2(v[q][i].x * r * g4[i].x, v[q][i].y * r * g4[i].y);
          o.y = pk2(v[q][i].z * r * g4[i].z, v[q][i].w * r * g4[i].w);
          *(uint2*)(XN + (size_t)(row0 + q) * 1024 + (lane + 64 * i) * 4) = o;
        }
      }
    }
  }
  {
    u16* PB = (u16*)(ws + WS_PB);
    const float4* ps = (const float4*)p.p;
    for (size_t i = gtid; i < (size_t)MTOK * 256 / 4; i += gn) {
      float4 v = ps[i];
      uint2 o;
      o.x = pk2(v.x, v.y);
      o.y = pk2(v.z, v.w);
      *(uint2*)(PB + i * 4) = o;
    }
  }
  {
    float* RC = (float*)(ws + WS_ROPEC);
    float* RS = (float*)(ws + WS_ROPES);
    float* SS = (float*)(ws + WS_SS1);
    for (size_t i = gtid; i < (size_t)SEQ * 8; i += gn) {
      int pos = (int)(i >> 3), fi = (int)(i & 7);
      float inv = fi == 0   ? 1.0f
                  : fi == 1 ? 0.1939227432012558f
                  : fi == 2 ? 0.03760603070259094f
                  : fi == 3 ? 0.007292664609849453f
                  : fi == 4 ? 0.0014142135623842478f
                  : fi == 5 ? 0.00027424818836152554f
                  : fi == 6 ? 5.318296098266728e-05f
                            : 1.0313386155758053e-05f;
      float ang = (float)pos * inv;
      double rev = (double)ang * 0.15915494309189535;
      rev -= floor(rev);
      float fr = (float)rev;
      RC[i] = __builtin_amdgcn_cosf(fr);
      RS[i] = __builtin_amdgcn_sinf(fr);
    }
    for (size_t i = gtid; i < (size_t)MTOK * 2; i += gn) SS[i] = 0.f;
  }
  {
    const int n_in = 16 * 56, n_out = 256, n_g = 256, n_p = 4 * 16, n_w1 = 32 * 2, n_w2 = 2;
    const int total = n_in + n_out + n_g + n_p + 2 * n_w1 + 2 * n_w2;
    for (int t = bid; t < total; t += nblk) {
      int u = t;
      const float* src;
      u16* dst;
      int R, C, tr, tc;
      if (u < n_in) { src = p.w_in; R = 1024; C = PP; dst = (u16*)(ws + WS_WTIN); tr = u / 56; tc = u % 56; }
      else if ((u -= n_in) < n_out) { src = p.w_out; R = 1024; C = 1024; dst = (u16*)(ws + WS_WTOUT); tr = u / 16; tc = u % 16; }
      else if ((u -= n_out) < n_g) { src = p.ple_gate; R = 1024; C = 1024; dst = (u16*)(ws + WS_WTG); tr = u / 16; tc = u % 16; }
      else if ((u -= n_g) < n_p) { src = p.ple_proj; R = 256; C = 1024; dst = (u16*)(ws + WS_WTP); tr = u / 16; tc = u % 16; }
      else if ((u -= n_p) < n_w1) { src = p.w1k; R = 2048; C = 128; dst = (u16*)(ws + WS_W1K); tr = u / 2; tc = u % 2; }
      else if ((u -= n_w1) < n_w1) { src = p.w1v; R = 2048; C = 128; dst = (u16*)(ws + WS_W1V); tr = u / 2; tc = u % 2; }
      else if ((u -= n_w1) < n_w2) { src = p.w2k; R = 128; C = 64; dst = (u16*)(ws + WS_W2K); tr = u; tc = 0; }
      else { u -= n_w2; src = p.w2v; R = 128; C = 64; dst = (u16*)(ws + WS_W2V); tr = u; tc = 0; }
      transpose_tile(src, R, C, dst, tr, tc);
    }
  }
}

__device__ __forceinline__ void phase2_rope(const Params& p) {
  unsigned char* ws = p.ws;
  u16* PJ = (u16*)(ws + WS_PROJ);
  const float* RC = (const float*)(ws + WS_ROPEC);
  const float* RS = (const float*)(ws + WS_ROPES);
  const size_t gtid = (size_t)blockIdx.x * NTHR + threadIdx.x, gn = (size_t)gridDim.x * NTHR;
  for (size_t i = gtid; i < (size_t)MTOK * 12; i += gn) {
    int tok = (int)(i / 12), slot = (int)(i % 12);
    int col = slot < 8 ? C_NQ + slot * 64 : (slot < 10 ? C_KS + (slot - 8) * 64 : C_KW + (slot - 10) * 64);
    int pos = tok & (SEQ - 1);
    u16* ptr = PJ + (size_t)tok * PP + col;
    U8 a, b, oa, ob;
    a.u = *(const uint4*)ptr;
    b.u = *(const uint4*)(ptr + 8);
    float4 c0 = *(const float4*)(RC + pos * 8), c1 = *(const float4*)(RC + pos * 8 + 4);
    float4 s0 = *(const float4*)(RS + pos * 8), s1 = *(const float4*)(RS + pos * 8 + 4);
    float cs[8] = {c0.x, c0.y, c0.z, c0.w, c1.x, c1.y, c1.z, c1.w};
    float sn[8] = {s0.x, s0.y, s0.z, s0.w, s1.x, s1.y, s1.z, s1.w};
#pragma unroll
    for (int k = 0; k < 8; ++k) {
      float x1 = bf2f(a.s[k]), x2 = bf2f(b.s[k]);
      oa.s[k] = f2bf(x1 * cs[k] - x2 * sn[k]);
      ob.s[k] = f2bf(x2 * cs[k] + x1 * sn[k]);
    }
    *(uint4*)ptr = oa.u;
    *(uint4*)(ptr + 8) = ob.u;
  }
}

__device__ __forceinline__ void phase2_vtrans(const Params& p) {
  unsigned char* ws = p.ws;
  const u16* PJ = (const u16*)(ws + WS_PROJ);
  u16* T = (u16*)smem;
  const int tid = threadIdx.x;
  for (int it = blockIdx.x; it < 1024; it += gridDim.x) {
    int which = it >> 9, b = (it >> 8) & 1, h = (it >> 7) & 1, tile = it & 127;
    int col0 = (which ? C_VW : C_VS) + h * 64;
    u16* dst = (u16*)(ws + (which ? WS_VWT : WS_VST));
    {
      int row = tid >> 3, ch = tid & 7;
      uint4 v = *(const uint4*)(PJ + (size_t)(b * SEQ + tile * 64 + row) * PP + col0 + ch * 8);
      *(uint4*)(T + row * 72 + ch * 8) = v;
    }
    __syncthreads();
    {
      int d = tid >> 3, tc = tid & 7;
      U8 o;
#pragma unroll
      for (int i = 0; i < 8; ++i) o.s[i] = T[(tc * 8 + i) * 72 + d];
      *(uint4*)(dst + ((size_t)(b * 2 + h) * 64 + d) * SEQ + tile * 64 + tc * 8) = o.u;
    }
    __syncthreads();
  }
}

__device__ __forceinline__ void phase2_compress(const Params& p) {
  unsigned char* ws = p.ws;
  const u16* PJ = (const u16*)(ws + WS_PROJ);
  const float* RC = (const float*)(ws + WS_ROPEC);
  const float* RS = (const float*)(ws + WS_ROPES);
  constexpr int AST = 2064;
  u16* AL = (u16*)smem;
  u16* H = (u16*)(smem + 16 * AST * 2);
  float* OF = (float*)(smem + 16 * AST * 2 + 16 * 136 * 2);
  const int tid = threadIdx.x, lane = tid & 63, w = tid >> 6, fr = lane & 15, fq = lane >> 4;
  for (int it = blockIdx.x; it < 256; it += gridDim.x) {
    int which = it >> 7, b = (it >> 6) & 1, h = (it >> 5) & 1, ct = it & 31;
    const int c0 = ct * 16;
    const int colbase = (which ? C_VC : C_KC) + h * 64;
    const float* pos = which ? p.pos_v : p.pos_k;
    const u16* W1 = (const u16*)(ws + (which ? WS_W1V : WS_W1K));
    const u16* W2 = (const u16*)(ws + (which ? WS_W2V : WS_W2K));
    const int n0 = w * 16;
    const u16* wrow = W1 + (size_t)(n0 + fr) * 2048 + fq * 8;
    U8 wbuf[2][16];
#pragma unroll
    for (int i = 0; i < 16; ++i) wbuf[0][i].u = *(const uint4*)(wrow + i * 32);
    {
      U8 xq[5];
#pragma unroll
      for (int q = 0; q < 5; ++q) {
        int u = tid + q * NTHR;
        u = u < 272 * 8 ? u : 272 * 8 - 1;
        int tok = c0 * 16 + (u >> 3);
        tok = tok > SEQ - 1 ? SEQ - 1 : tok;
        xq[q].u = *(const uint4*)(PJ + (size_t)(b * SEQ + tok) * PP + colbase + (u & 7) * 8);
      }
#pragma unroll
      for (int q = 0; q < 5; ++q) {
        const int u = tid + q * NTHR;
        if (u < 272 * 8) {
          const int tl = u >> 3, ch = u & 7;
          const int cl = tl >> 4, l = tl & 15;
          float xv[8];
#pragma unroll
          for (int k = 0; k < 8; ++k) xv[k] = bf2f(xq[q].s[k]);
          if (cl <= 15) {
            float4 p0 = *(const float4*)(pos + l * 64 + ch * 8), p1 = *(const float4*)(pos + l * 64 + ch * 8 + 4);
            uint4 o;
            o.x = pk2(xv[0] + p0.x, xv[1] + p0.y);
            o.y = pk2(xv[2] + p0.z, xv[3] + p0.w);
            o.z = pk2(xv[4] + p1.x, xv[5] + p1.y);
            o.w = pk2(xv[6] + p1.z, xv[7] + p1.w);
            *(uint4*)(AL + cl * AST + l * 64 + ch * 8) = o;
          }
          if (cl >= 1) {
            int l2 = l + 16;
            float4 p0 = *(const float4*)(pos + l2 * 64 + ch * 8), p1 = *(const float4*)(pos + l2 * 64 + ch * 8 + 4);
            uint4 o;
            o.x = pk2(xv[0] + p0.x, xv[1] + p0.y);
            o.y = pk2(xv[2] + p0.z, xv[3] + p0.w);
            o.z = pk2(xv[4] + p1.x, xv[5] + p1.y);
            o.w = pk2(xv[6] + p1.z, xv[7] + p1.w);
            *(uint4*)(AL + (cl - 1) * AST + l2 * 64 + ch * 8) = o;
          }
        }
      }
    }
    __syncthreads();
    f32x4 acc = {0.f, 0.f, 0.f, 0.f};
    const u16* arow = AL + fr * AST + fq * 8;
#pragma unroll
    for (int bt = 0; bt < 4; ++bt) {
      if (bt + 1 < 4) {
#pragma unroll
        for (int i = 0; i < 16; ++i) wbuf[(bt + 1) & 1][i].u = *(const uint4*)(wrow + ((bt + 1) * 16 + i) * 32);
      }
#pragma unroll
      for (int i = 0; i < 16; ++i) {
        U8 aa;
        aa.u = *(const uint4*)(arow + (bt * 16 + i) * 32);
        acc = __builtin_amdgcn_mfma_f32_16x16x32_bf16(aa.v, wbuf[bt & 1][i].v, acc, 0, 0, 0);
      }
    }
#pragma unroll
    for (int j = 0; j < 4; ++j) H[(fq * 4 + j) * 136 + n0 + fr] = f2bf(siluf_(acc[j]));
    __syncthreads();
    if (w < 4) {
      f32x4 a2 = {0.f, 0.f, 0.f, 0.f};
#pragma unroll
      for (int ks = 0; ks < 4; ++ks) {
        U8 ha, wb;
        ha.u = *(const uint4*)(H + fr * 136 + ks * 32 + fq * 8);
        wb.u = *(const uint4*)(W2 + (size_t)(w * 16 + fr) * 128 + ks * 32 + fq * 8);
        a2 = __builtin_amdgcn_mfma_f32_16x16x32_bf16(ha.v, wb.v, a2, 0, 0, 0);
      }
#pragma unroll
      for (int j = 0; j < 4; ++j) OF[(fq * 4 + j) * 64 + w * 16 + fr] = a2[j];
    }
    __syncthreads();
    {
      int cl = tid >> 5, dd = tid & 31;
      int c = c0 + cl;
      float v0 = OF[cl * 64 + dd], v1 = OF[cl * 64 + dd + 32];
      if (which == 0) {
        if (dd < 16) {
          int partner = dd < 8 ? dd + 8 : dd - 8;
          float y = OF[cl * 64 + partner];
          int ps = c * 16 + 31;
          ps = ps > SEQ - 1 ? SEQ - 1 : ps;
          float cs = RC[ps * 8 + (dd & 7)], sn = RS[ps * 8 + (dd & 7)];
          v0 = dd < 8 ? v0 * cs - y * sn : v0 * cs + y * sn;
        }
        u16* KC = (u16*)(ws + WS_KC);
        KC[((size_t)(b * 2 + h) * 512 + c) * 64 + dd] = f2bf(v0);
        KC[((size_t)(b * 2 + h) * 512 + c) * 64 + dd + 32] = f2bf(v1);
      } else {
        u16* VCT = (u16*)(ws + WS_VCT);
        VCT[((size_t)(b * 2 + h) * 64 + dd) * 512 + c] = f2bf(v0);
        VCT[((size_t)(b * 2 + h) * 64 + dd + 32) * 512 + c] = f2bf(v1);
      }
    }
    __syncthreads();
  }
}

__device__ __forceinline__ float logsig(float u) { return fminf(u, 0.f) - __logf(1.f + __expf(-fabsf(u))); }

__device__ __forceinline__ void phase2_gla1(const Params& p) {
  unsigned char* ws = p.ws;
  const u16* PJ = (const u16*)(ws + WS_PROJ);
  float* BC = (float*)(ws + WS_BCUM);
  u16* DS = (u16*)(ws + WS_DS);
  float* DEC = (float*)(ws + WS_DEC);
  float* GA = (float*)smem;
  float* PART = GA + 1024;
  u16* KT = (u16*)(PART + 512);
  u16* VT = KT + 256 * 72;
  const int tid = threadIdx.x, lane = tid & 63, w = tid >> 6, r = lane & 31, hh = lane >> 5;
  for (int it = blockIdx.x; it < 256; it += gridDim.x) {
    const int b = it >> 7, c = it & 127;
    const size_t tok0 = (size_t)b * SEQ + c * 64;
    for (int i = tid; i < 1024; i += NTHR) GA[i] = bf2f(PJ[(tok0 + (i >> 4)) * PP + C_GA + (i & 15)]);
    const int col = tid & 255, tg = tid >> 8;
    float au[16];
#pragma unroll
    for (int rr = 0; rr < 16; ++rr) au[rr] = p.a_up[rr * 256 + col];
    const float bias = p.a_bias[col];
    u16 kraw[32];
#pragma unroll
    for (int tt = 0; tt < 32; ++tt) kraw[tt] = PJ[(tok0 + tg * 32 + tt) * PP + C_GK + col];
    {
      const int vc = tid;
#pragma unroll
      for (int t8 = 0; t8 < 8; ++t8) {
        U8 o;
#pragma unroll
        for (int i = 0; i < 8; ++i) o.s[i] = PJ[(tok0 + t8 * 8 + i) * PP + C_GV + vc];
        *(uint4*)(VT + vc * 72 + t8 * 8) = o.u;
      }
    }
    __syncthreads();
    float pre[32];
    {
      float run = 0.f;
#pragma unroll
      for (int tt = 0; tt < 32; ++tt) {
        const int t = tg * 32 + tt;
        float u = bias;
#pragma unroll
        for (int rr = 0; rr < 16; ++rr) u += GA[t * 16 + rr] * au[rr];
        run += logsig(u) * (1.f / 16.f);
        pre[tt] = run;
      }
      PART[tg * 256 + col] = run;
    }
    __syncthreads();
    {
      const float p0 = PART[col], p1 = PART[256 + col];
      const float off = tg ? p0 : 0.f, blast = p0 + p1;
#pragma unroll
      for (int t8 = 0; t8 < 4; ++t8) {
        U8 o;
#pragma unroll
        for (int i = 0; i < 8; ++i) {
          const int tt = t8 * 8 + i;
          const float bv = off + pre[tt];
          BC[(tok0 + tg * 32 + tt) * 256 + col] = bv;
          o.s[i] = f2bf(bf2f(kraw[tt]) * __expf(blast - bv));
        }
        *(uint4*)(KT + col * 72 + tg * 32 + t8 * 8) = o.u;
      }
      if (tg == 0) DEC[((size_t)((b * 4 + (col >> 6)) * 128 + c)) * 64 + (col & 63)] = __expf(blast);
    }
    __syncthreads();
    {
      const int h = w >> 1, kt = w & 1;
      bf16x8 afr[4];
#pragma unroll
      for (int ts = 0; ts < 4; ++ts) {
        U8 a;
        a.u = *(const uint4*)(KT + (h * 64 + kt * 32 + r) * 72 + ts * 16 + hh * 8);
        afr[ts] = a.v;
      }
      const size_t item = (size_t)((b * 4 + h) * 128 + c);
#pragma unroll 1
      for (int vt = 0; vt < 4; ++vt) {
        f32x16 acc;
#pragma unroll
        for (int i = 0; i < 16; ++i) acc[i] = 0.f;
#pragma unroll
        for (int ts = 0; ts < 4; ++ts) {
          U8 bq;
          bq.u = *(const uint4*)(VT + (h * 128 + vt * 32 + r) * 72 + ts * 16 + hh * 8);
          acc = mfma32(afr[ts], bq.v, acc);
        }
#pragma unroll
        for (int i = 0; i < 16; ++i) {
          int kk = kt * 32 + (i & 3) + 8 * (i >> 2) + 4 * hh;
          DS[item * 8192 + kk * 128 + vt * 32 + r] = f2bf(acc[i]);
        }
      }
    }
    __syncthreads();
  }
}

__device__ __forceinline__ void phase3_scan(const Params& p) {
  unsigned char* ws = p.ws;
  u16* DS = (u16*)(ws + WS_DS);
  const float* DEC = (const float*)(ws + WS_DEC);
  const size_t gtid = (size_t)blockIdx.x * NTHR + threadIdx.x, gn = (size_t)gridDim.x * NTHR;
  for (size_t e = gtid; e < 65536; e += gn) {
    int bh = (int)(e >> 13), kv = (int)(e & 8191), k = kv >> 7;
    float S = 0.f;
    for (int c0 = 0; c0 < 128; c0 += 32) {
      float tmp[32], dc[32];
#pragma unroll
      for (int i = 0; i < 32; ++i) {
        tmp[i] = bf2f(DS[((size_t)(bh * 128 + c0 + i)) * 8192 + kv]);
        dc[i] = DEC[(size_t)(bh * 128 + c0 + i) * 64 + k];
      }
#pragma unroll
      for (int i = 0; i < 32; ++i) {
        DS[((size_t)(bh * 128 + c0 + i)) * 8192 + kv] = f2bf(S);
        S = dc[i] * S + tmp[i];
      }
    }
  }
}

__device__ __forceinline__ void phase4_gla3(const Params& p) {
  unsigned char* ws = p.ws;
  const u16* PJ = (const u16*)(ws + WS_PROJ);
  const float* BC = (const float*)(ws + WS_BCUM);
  const u16* DS = (const u16*)(ws + WS_DS);
  u16* MIX = (u16*)(ws + WS_XN);
  u16* QT = (u16*)smem;
  u16* KP = QT + 2 * 64 * 72;
  u16* ST = KP + 2 * 64 * 72;
  u16* VT = ST + 2 * 128 * 72;
  float* RED = (float*)(VT + 2 * 128 * 72);
  const int tid = threadIdx.x, lane = tid & 63, w = tid >> 6, r = lane & 31, hh = lane >> 5;
  for (int it = blockIdx.x; it < 512; it += gridDim.x) {
    const int b = it >> 8, c = (it >> 1) & 127, hp = it & 1;
    const size_t tok0 = (size_t)b * SEQ + c * 64;
    {
      const int colq = tid & 127, tg = tid >> 7;
      const int hd = colq >> 6, k = colq & 63, hcol = (hp * 2 + hd) * 64 + k;
      float bv[16];
      u16 qv[16], kv[16];
#pragma unroll
      for (int tt = 0; tt < 16; ++tt) {
        const size_t tok = tok0 + tg * 16 + tt;
        bv[tt] = BC[tok * 256 + hcol];
        qv[tt] = PJ[tok * PP + C_GQ + hcol];
        kv[tt] = PJ[tok * PP + C_GK + hcol];
      }
      const int vcol = tid & 255, half = tid >> 8;
      const int hd2 = vcol >> 7, v = vcol & 127;
      const size_t item = (size_t)((b * 4 + hp * 2 + hd2) * 128 + c);
      u16 sv[32];
      u16 vv[32];
#pragma unroll
      for (int i = 0; i < 32; ++i) {
        sv[i] = DS[item * 8192 + (half * 32 + i) * 128 + v];
        vv[i] = PJ[(tok0 + half * 32 + i) * PP + C_GV + (hp * 2 + hd2) * 128 + v];
      }
#pragma unroll
      for (int tt = 0; tt < 16; ++tt) {
        const int t = tg * 16 + tt;
        QT[(hd * 64 + t) * 72 + k] = f2bf(bf2f(qv[tt]) * 0.125f * __expf(bv[tt]));
        KP[(hd * 64 + t) * 72 + k] = f2bf(bf2f(kv[tt]) * __expf(-bv[tt]));
      }
#pragma unroll
      for (int q8 = 0; q8 < 4; ++q8) {
        U8 so, vo;
#pragma unroll
        for (int i = 0; i < 8; ++i) so.s[i] = sv[q8 * 8 + i];
#pragma unroll
        for (int i = 0; i < 8; ++i) vo.s[i] = vv[q8 * 8 + i];
        *(uint4*)(ST + (hd2 * 128 + v) * 72 + half * 32 + q8 * 8) = so.u;
        *(uint4*)(VT + (hd2 * 128 + v) * 72 + half * 32 + q8 * 8) = vo.u;
      }
    }
    __syncthreads();
    const int itile = w & 1, vt = w >> 1;
    uint2 zpre[2][4];
#pragma unroll
    for (int hd = 0; hd < 2; ++hd)
#pragma unroll
      for (int q4 = 0; q4 < 4; ++q4)
        zpre[hd][q4] = *(const uint2*)(PJ + (tok0 + itile * 32 + r) * PP + C_GZ + (hp * 2 + hd) * 128 + vt * 32 + 8 * q4 + 4 * hh);
    f32x16 o[2];
#pragma unroll
    for (int hd = 0; hd < 2; ++hd) {
      const u16* QTh = QT + hd * 64 * 72;
      const u16* KPh = KP + hd * 64 * 72;
      const u16* STh = ST + hd * 128 * 72;
      const u16* VTh = VT + hd * 128 * 72;
#pragma unroll
      for (int i = 0; i < 16; ++i) o[hd][i] = 0.f;
      bf16x8 qfr[4];
#pragma unroll
      for (int ks = 0; ks < 4; ++ks) {
        U8 q;
        q.u = *(const uint4*)(QTh + (itile * 32 + r) * 72 + ks * 16 + hh * 8);
        qfr[ks] = q.v;
        U8 a;
        a.u = *(const uint4*)(STh + (vt * 32 + r) * 72 + ks * 16 + hh * 8);
        o[hd] = mfma32(a.v, q.v, o[hd]);
      }
      for (int jt = 0; jt <= itile; ++jt) {
        f32x16 s;
#pragma unroll
        for (int i = 0; i < 16; ++i) s[i] = 0.f;
#pragma unroll
        for (int ks = 0; ks < 4; ++ks) {
          U8 a;
          a.u = *(const uint4*)(KPh + (jt * 32 + r) * 72 + ks * 16 + hh * 8);
          s = mfma32(a.v, qfr[ks], s);
        }
        const int ii = itile * 32 + r;
#pragma unroll
        for (int i = 0; i < 16; ++i) {
          int j = jt * 32 + (i & 3) + 8 * (i >> 2) + 4 * hh;
          if (j > ii) s[i] = 0.f;
        }
#pragma unroll
        for (int s2 = 0; s2 < 2; ++s2) {
          U8 pb, va;
          pb.u.x = pk2(s[8 * s2 + 0], s[8 * s2 + 1]);
          pb.u.y = pk2(s[8 * s2 + 2], s[8 * s2 + 3]);
          pb.u.z = pk2(s[8 * s2 + 4], s[8 * s2 + 5]);
          pb.u.w = pk2(s[8 * s2 + 6], s[8 * s2 + 7]);
          const u16* vp = VTh + (vt * 32 + r) * 72 + jt * 32 + s2 * 16 + hh * 4;
          va.h[0] = *(const uint2*)vp;
          va.h[1] = *(const uint2*)(vp + 8);
          o[hd] = mfma32(va.v, pb.v, o[hd]);
        }
      }
      float ss = 0.f;
#pragma unroll
      for (int i = 0; i < 16; ++i) ss += o[hd][i] * o[hd][i];
      ss += __shfl_xor(ss, 32);
      if (hh == 0) RED[(hd * 4 + vt) * 64 + itile * 32 + r] = ss;
    }
    __syncthreads();
#pragma unroll
    for (int hd = 0; hd < 2; ++hd) {
      const int h = hp * 2 + hd;
      const int ti = itile * 32 + r;
      const float* R4 = RED + hd * 256;
      float tot = R4[ti] + R4[64 + ti] + R4[128 + ti] + R4[192 + ti];
      float rstd = rsqrtf(tot * (1.f / 128.f) + EPSV);
      const size_t tok = tok0 + ti;
#pragma unroll
      for (int q4 = 0; q4 < 4; ++q4) {
        int v0 = vt * 32 + 8 * q4 + 4 * hh;
        uint2 zz = zpre[hd][q4];
        float4 gn = *(const float4*)(p.gnorm + v0);
        float z0 = bf2f((u16)(zz.x & 0xFFFF)), z1 = bf2f((u16)(zz.x >> 16)), z2 = bf2f((u16)(zz.y & 0xFFFF)),
              z3 = bf2f((u16)(zz.y >> 16));
        uint2 ov;
        ov.x = pk2(o[hd][4 * q4 + 0] * rstd * gn.x * siluf_(z0), o[hd][4 * q4 + 1] * rstd * gn.y * siluf_(z1));
        ov.y = pk2(o[hd][4 * q4 + 2] * rstd * gn.z * siluf_(z2), o[hd][4 * q4 + 3] * rstd * gn.w * siluf_(z3));
        *(uint2*)(MIX + tok * 1024 + h * 128 + v0) = ov;
      }
    }
    __syncthreads();
  }
}

constexpr int NSA_BUF = 18432;
constexpr int NSA_IMP_OFF = 2 * NSA_BUF;
constexpr int NSA_SEL_OFF = NSA_IMP_OFF + 64 * 128 * 4;
constexpr int NSA_OFIN_OFF = NSA_SEL_OFF + 1024;

__device__ __forceinline__ void tile_load(const u16* kp, int kpitch, const u16* vp, int vpitch, uint4& kr, uint4& vr) {
  int row = threadIdx.x >> 3, ch = threadIdx.x & 7;
  kr = *(const uint4*)(kp + (size_t)row * kpitch + ch * 8);
  vr = *(const uint4*)(vp + (size_t)row * vpitch + ch * 8);
}
__device__ __forceinline__ void tile_store(unsigned char* buf, uint4 kr, uint4 vr) {
  int row = threadIdx.x >> 3, ch = threadIdx.x & 7;
  *(uint4*)(buf + row * 144 + ch * 16) = kr;
  unsigned char* vb = buf + 9216 + row * 144 + (ch >> 1) * 32 + (ch & 1) * 8;
  *(uint2*)vb = make_uint2(vr.x, vr.y);
  *(uint2*)(vb + 16) = make_uint2(vr.z, vr.w);
}

template <int KIND, bool PRE = false>
__device__ __forceinline__ void nsa_segment(const u16* kp0, size_t kstride, int kpitch, const u16* vp0, size_t vstride,
                                            int vpitch, int nsteps, const bf16x8 (&qf)[4], f32x16 (&o)[2], float& mrun,
                                            float& lrun, int m_tile, int tl, int imax, unsigned long long sel_lo, unsigned long long sel_hi, float cm,
                                            float cinvl, int tokl, int g, int kb0, uint4 pre_k = uint4(), uint4 pre_v = uint4()) {
  const int lane = threadIdx.x & 63, r = lane & 31, hh = lane >> 5;
  float* imp = (float*)(smem + NSA_IMP_OFF);
  uint4 krA, vrA, krB, vrB;
  if (PRE) { krA = pre_k; vrA = pre_v; }
  else tile_load(kp0, kpitch, vp0, vpitch, krA, vrA);
  tile_store(smem, krA, vrA);
  {
    const int t1 = nsteps > 1 ? 1 : 0;
    tile_load(kp0 + (size_t)t1 * kstride, kpitch, vp0 + (size_t)t1 * vstride, vpitch, krA, vrA);
  }
  __syncthreads();
  auto body = [&](int s, uint4& k_issue, uint4& v_issue, uint4& k_store, uint4& v_store) {
    unsigned char* cur = smem + (s & 1) * NSA_BUF;
    unsigned char* nxt = smem + ((s + 1) & 1) * NSA_BUF;
    {
      const int tn = (s + 2 < nsteps) ? s + 2 : nsteps - 1;
      tile_load(kp0 + (size_t)tn * kstride, kpitch, vp0 + (size_t)tn * vstride, vpitch, k_issue, v_issue);
    }
    bool masked = false, rowvalid = true;
    int hi = 63, lo = -1;
    if (KIND <= 1) {
      masked = true;
      hi = imax - 64 * s;
      rowvalid = hi >= 0;
    } else if (KIND == 2) {
      if (s == m_tile) {
        masked = true;
        hi = tl;
      } else {
        unsigned long long sw = s < 64 ? sel_lo : sel_hi;
        rowvalid = (sw >> (s & 63)) & 1ull;
      }
    } else {
      int kb = kb0 + s;
      if (kb == m_tile - 8) {
        masked = true;
        lo = tl;
      } else if (kb == m_tile) {
        masked = true;
        hi = tl;
      }
    }
    if (s < nsteps && __ballot(rowvalid) != 0ull) {
      f32x16 sc[2];
      U8 kf[8];
#pragma unroll
      for (int kt = 0; kt < 2; ++kt)
#pragma unroll
        for (int ds = 0; ds < 4; ++ds) kf[kt * 4 + ds].u = *(const uint4*)(cur + (kt * 32 + r) * 144 + ds * 32 + hh * 16);
      __builtin_amdgcn_sched_barrier(0);
#pragma unroll
      for (int kt = 0; kt < 2; ++kt) {
#pragma unroll
        for (int i = 0; i < 16; ++i) sc[kt][i] = 0.f;
#pragma unroll
        for (int ds = 0; ds < 4; ++ds) sc[kt] = mfma32(kf[kt * 4 + ds].v, qf[ds], sc[kt]);
      }
      U8 vf[8];
      if (KIND >= 1) {
#pragma unroll
        for (int kt = 0; kt < 2; ++kt)
#pragma unroll
          for (int s2 = 0; s2 < 2; ++s2)
#pragma unroll
            for (int dt = 0; dt < 2; ++dt) {
              vf[(kt * 2 + s2) * 2 + dt].u = *(const uint4*)(cur + 9216 + (dt * 32 + r) * 144 + (kt * 2 + s2) * 32 + hh * 16);
            }
      }
      __builtin_amdgcn_sched_barrier(0);
      const float NEG_INF = -__builtin_inff();
      if (KIND == 1) {
#pragma unroll
        for (int kt = 0; kt < 2; ++kt)
#pragma unroll
          for (int i = 0; i < 16; ++i) {
            int kl = kt * 32 + (i & 3) + 8 * (i >> 2) + 4 * hh;
            float pv = ex2(sc[kt][i] * QSCALE_L2 - cm) * cinvl;
            sc[kt][i] = (kl <= hi) ? pv : 0.f;
          }
#pragma unroll
        for (int kt = 0; kt < 2; ++kt)
#pragma unroll
          for (int q4 = 0; q4 < 4; ++q4) {
            float s4 = sc[kt][4 * q4] + sc[kt][4 * q4 + 1] + sc[kt][4 * q4 + 2] + sc[kt][4 * q4 + 3];
            float sp = sc[kt][4 * q4 + 3];
            s4 = quad_sum(s4);
            sp = quad_sum(sp);
            if (g == 0) {
              int jb = (64 * s + kt * 32 + 8 * q4 + 4 * hh) >> 2;
              atomicAdd(&imp[tokl * 128 + jb], s4);
              if (jb + 1 < 128) atomicAdd(&imp[tokl * 128 + jb + 1], sp);
            }
          }
      } else {
        float mx = NEG_INF;
        if (masked) {
#pragma unroll
          for (int kt = 0; kt < 2; ++kt)
#pragma unroll
            for (int i = 0; i < 16; ++i) {
              int kl = kt * 32 + (i & 3) + 8 * (i >> 2) + 4 * hh;
              bool ok = (kl <= hi) && (kl > lo);
              sc[kt][i] = ok ? sc[kt][i] : NEG_INF;
              mx = fmaxf(mx, sc[kt][i]);
            }
        } else {
#pragma unroll
          for (int kt = 0; kt < 2; ++kt)
#pragma unroll
            for (int i = 0; i < 16; ++i) mx = fmaxf(mx, sc[kt][i]);
          if (!rowvalid) mx = NEG_INF;
        }
        mx = fmaxf(mx, __shfl_xor(mx, 32));
        const float mxc = mx * QSCALE_L2;
        const bool need = mxc > mrun + 8.f;
        if (__ballot(need) != 0ull) {
          float mnew = need ? mxc : mrun;
          float alpha = ex2(mrun - mnew);
          lrun *= alpha;
          mrun = mnew;
          if (KIND >= 2) {
#pragma unroll
            for (int dt = 0; dt < 2; ++dt)
#pragma unroll
              for (int i = 0; i < 16; ++i) o[dt][i] *= alpha;
          }
        }
        float moff = (masked || rowvalid) ? mrun : __builtin_inff();
        float psum = 0.f;
#pragma unroll
        for (int kt = 0; kt < 2; ++kt)
#pragma unroll
          for (int i = 0; i < 16; ++i) {
            float pv = ex2(sc[kt][i] * QSCALE_L2 - moff);
            sc[kt][i] = pv;
            psum += pv;
          }
        lrun += psum;
      }
      if (KIND >= 1) {
#pragma unroll
        for (int kt = 0; kt < 2; ++kt)
#pragma unroll
          for (int s2 = 0; s2 < 2; ++s2) {
            U8 pb;
            pb.u.x = pk2(sc[kt][8 * s2 + 0], sc[kt][8 * s2 + 1]);
            pb.u.y = pk2(sc[kt][8 * s2 + 2], sc[kt][8 * s2 + 3]);
            pb.u.z = pk2(sc[kt][8 * s2 + 4], sc[kt][8 * s2 + 5]);
            pb.u.w = pk2(sc[kt][8 * s2 + 6], sc[kt][8 * s2 + 7]);
#pragma unroll
            for (int dt = 0; dt < 2; ++dt) o[dt] = mfma32(vf[(kt * 2 + s2) * 2 + dt].v, pb.v, o[dt]);
          }
      }
    }
    tile_store(nxt, k_store, v_store);
    __syncthreads();
  };
  const int nst2 = (nsteps + 1) & ~1;
  for (int s = 0; s < nst2; s += 2) {
    body(s, krB, vrB, krA, vrA);
    body(s + 1, krA, vrA, krB, vrB);
  }
}

__device__ __forceinline__ void nsa_item(const Params& p, int b, int kvh, int m) {
  unsigned char* ws = p.ws;
  const u16* PJ = (const u16*)(ws + WS_PROJ);
  u16* MIX = (u16*)(ws + WS_XN);
  int tid = threadIdx.x;
  asm volatile("" : "+v"(tid));
  const int lane = tid & 63, w = tid >> 6, r = lane & 31, hh = lane >> 5;
  const int tokl = 8 * w + (r >> 2), g = r & 3, head = kvh * 4 + g;
  const int q0 = m * 64, t = q0 + tokl;
  const size_t tokg = (size_t)b * SEQ + t;
  float* imp = (float*)(smem + NSA_IMP_OFF);
  unsigned* selw = (unsigned*)(smem + NSA_SEL_OFF);
  for (int i = tid; i < 64 * 128; i += NTHR) imp[i] = 0.f;
  bf16x8 qf[4];
#pragma unroll
  for (int ds = 0; ds < 4; ++ds) {
    U8 q;
    q.u = *(const uint4*)(PJ + tokg * PP + C_NQ + head * 64 + ds * 16 + hh * 8);
    qf[ds] = q.v;
  }
  float gate[3];
#pragma unroll
  for (int br = 0; br < 3; ++br) gate[br] = sigmoidf_(bf2f(PJ[tokg * PP + C_NG + head * 3 + br]));
  f32x16 o[2];
  float* ofl = (float*)(smem + NSA_OFIN_OFF) + tid;
#pragma unroll
  for (int dt = 0; dt < 2; ++dt)
#pragma unroll
    for (int i = 0; i < 16; ++i) o[dt][i] = 0.f;
  unsigned long long sel_lo = 0ull, sel_hi = 0ull;
  const int imax = (t - 31) >> 4;
  {
    const int nct = ((4 * m + 2) >> 6) + 1;
    const u16* kc = (const u16*)(ws + WS_KC) + (size_t)(b * 2 + kvh) * 512 * 64;
    const u16* vct = (const u16*)(ws + WS_VCT) + (size_t)(b * 2 + kvh) * 64 * 512;
    float mrun = -1e30f, lrun = 0.f;
    nsa_segment<0>(kc, 64 * 64, 64, vct, 64, 512, nct, qf, o, mrun, lrun, m, tokl, imax, sel_lo, sel_hi, 0.f, 0.f, tokl, g, 0);
    float ltot = lrun + __shfl_xor(lrun, 32);
    float cinvl = ltot > 0.f ? 1.f / ltot : 0.f;
    float dm = 0.f, dl = 0.f;
    nsa_segment<1>(kc, 64 * 64, 64, vct, 64, 512, nct, qf, o, dm, dl, m, tokl, imax, sel_lo, sel_hi, mrun, cinvl, tokl, g, 0);
#pragma unroll
    for (int dt = 0; dt < 2; ++dt)
#pragma unroll
      for (int i = 0; i < 16; ++i) { ofl[(dt * 16 + i) * NTHR] = o[dt][i] * gate[0]; o[dt][i] = 0.f; }
  }
  uint4 slc_k0, slc_v0;
  tile_load(PJ + (size_t)b * SEQ * PP + C_KS + kvh * 64, PP, (const u16*)(ws + WS_VST) + (size_t)(b * 2 + kvh) * 64 * SEQ, SEQ, slc_k0, slc_v0);
  __syncthreads();
  if (m < 16) {
    sel_lo = (1ull << (m + 1)) - 1ull;
  } else {
    {
      const int tk = lane >> 3, sub = lane & 7;
      const int tl2 = 8 * w + tk;
      unsigned key[16];
#pragma unroll
      for (int i = 0; i < 16; ++i) {
        const int j = sub + 8 * i;
        unsigned kv = (__float_as_uint(imp[tl2 * 128 + j]) & 0xFFFFFF80u) | (unsigned)(127 - j);
        key[i] = (j >= 1 && j <= m - 2) ? kv : 0u;
      }
      unsigned tau = 0u;
      for (int bit = 30; bit >= 0; --bit) {
        const unsigned cand = tau | (1u << bit);
        int cnt = 0;
#pragma unroll
        for (int i = 0; i < 16; ++i) cnt += (key[i] >= cand) ? 1 : 0;
        cnt += __builtin_amdgcn_mov_dpp(cnt, 0xB1, 0xF, 0xF, true);
        cnt += __builtin_amdgcn_mov_dpp(cnt, 0x4E, 0xF, 0xF, true);
        cnt += __builtin_amdgcn_mov_dpp(cnt, 0x141, 0xF, 0xF, true);
        if (cnt >= 13) tau = cand;
      }
      unsigned wsel[4] = {0u, 0u, 0u, 0u};
#pragma unroll
      for (int i = 0; i < 16; ++i)
        if (key[i] >= tau && key[i] != 0u) wsel[i >> 2] |= 1u << (8 * (i & 3) + sub);
#pragma unroll
      for (int q = 0; q < 4; ++q) {
        unsigned v = wsel[q];
        v |= (unsigned)__builtin_amdgcn_mov_dpp((int)v, 0xB1, 0xF, 0xF, true);
        v |= (unsigned)__builtin_amdgcn_mov_dpp((int)v, 0x4E, 0xF, 0xF, true);
        v |= (unsigned)__builtin_amdgcn_mov_dpp((int)v, 0x141, 0xF, 0xF, true);
        wsel[q] = v;
      }
      wsel[0] |= 1u;
      {
        const int f1 = m, f2 = m - 1;
#pragma unroll
        for (int q = 0; q < 4; ++q) {
          if ((f1 >> 5) == q) wsel[q] |= 1u << (f1 & 31);
          if ((f2 >> 5) == q) wsel[q] |= 1u << (f2 & 31);
        }
      }
      if (sub == 0) {
        selw[tl2 * 4 + 0] = wsel[0];
        selw[tl2 * 4 + 1] = wsel[1];
        selw[tl2 * 4 + 2] = wsel[2];
        selw[tl2 * 4 + 3] = wsel[3];
      }
    }
    __syncthreads();
    sel_lo = (unsigned long long)selw[tokl * 4 + 0] | ((unsigned long long)selw[tokl * 4 + 1] << 32);
    sel_hi = (unsigned long long)selw[tokl * 4 + 2] | ((unsigned long long)selw[tokl * 4 + 3] << 32);
  }
  {
    const u16* kp = PJ + (size_t)b * SEQ * PP + C_KS + kvh * 64;
    const u16* vp = (const u16*)(ws + WS_VST) + (size_t)(b * 2 + kvh) * 64 * SEQ;
    float mrun = -1e30f, lrun = 0.f;
    nsa_segment<2, true>(kp, (size_t)64 * PP, PP, vp, 64, SEQ, m + 1, qf, o, mrun, lrun, m, tokl, imax, sel_lo, sel_hi, 0.f, 0.f, tokl, g, 0, slc_k0, slc_v0);
    float ltot = lrun + __shfl_xor(lrun, 32);
    float sc = gate[1] / ltot;
#pragma unroll
    for (int dt = 0; dt < 2; ++dt)
#pragma unroll
      for (int i = 0; i < 16; ++i) { ofl[(dt * 16 + i) * NTHR] += o[dt][i] * sc; o[dt][i] = 0.f; }
  }
  {
    const int kb0 = m >= 8 ? m - 8 : 0;
    const u16* kp = PJ + ((size_t)b * SEQ + (size_t)kb0 * 64) * PP + C_KW + kvh * 64;
    const u16* vp = (const u16*)(ws + WS_VWT) + (size_t)(b * 2 + kvh) * 64 * SEQ + (size_t)kb0 * 64;
    float mrun = -1e30f, lrun = 0.f;
    nsa_segment<3>(kp, (size_t)64 * PP, PP, vp, 64, SEQ, m - kb0 + 1, qf, o, mrun, lrun, m, tokl, imax, sel_lo, sel_hi, 0.f, 0.f, tokl, g, kb0);
    float ltot = lrun + __shfl_xor(lrun, 32);
    float sc = gate[2] / ltot;
#pragma unroll
    for (int dt = 0; dt < 2; ++dt)
#pragma unroll
      for (int i = 0; i < 16; ++i) o[dt][i] = ofl[(dt * 16 + i) * NTHR] + o[dt][i] * sc;
  }
#pragma unroll
  for (int dt = 0; dt < 2; ++dt)
#pragma unroll
    for (int q4 = 0; q4 < 4; ++q4) {
      int d0 = dt * 32 + 8 * q4 + 4 * hh;
      uint2 zz = *(const uint2*)(PJ + tokg * PP + C_NZ + head * 64 + d0);
      float z0 = bf2f((u16)(zz.x & 0xFFFF)), z1 = bf2f((u16)(zz.x >> 16)), z2 = bf2f((u16)(zz.y & 0xFFFF)),
            z3 = bf2f((u16)(zz.y >> 16));
      uint2 ov;
      ov.x = pk2(o[dt][4 * q4 + 0] * siluf_(z0), o[dt][4 * q4 + 1] * siluf_(z1));
      ov.y = pk2(o[dt][4 * q4 + 2] * siluf_(z2), o[dt][4 * q4 + 3] * siluf_(z3));
      *(uint2*)(MIX + tokg * 1024 + 512 + head * 64 + d0) = ov;
    }
  __syncthreads();
}

__device__ __forceinline__ void phase4_nsa(const Params& p) {
  for (int wk = blockIdx.x; wk < 256; wk += gridDim.x) {
    int bk = wk >> 6, i = wk & 63;
#pragma unroll 1
    for (int rep = 0; rep < 2; ++rep) nsa_item(p, bk >> 1, bk & 1, rep ? i : 127 - i);
  }
}

__device__ __forceinline__ void phase6_res(const Params& p) {
  unsigned char* ws = p.ws;
  const uint2* MX = (const uint2*)(ws + WS_PROJ);
  const float* SS = (const float*)(ws + WS_SS1);
  u16* HB = (u16*)(ws + WS_XN);
  const size_t gtid = (size_t)blockIdx.x * NTHR + threadIdx.x, gn = (size_t)gridDim.x * NTHR;
  for (size_t i = gtid; i < (size_t)MTOK * 256; i += gn) {
    int row = (int)(i >> 8), c4 = (int)(i & 255);
    float rstd = rsqrtf(SS[row] * (1.f / 1024.f) + EPSV);
    uint2 mb = MX[i];
    float4 xv = ((const float4*)p.x)[i], gv = ((const float4*)p.post_norm)[c4];
    float4 hv;
    hv.x = xv.x + bf2f((u16)(mb.x & 0xFFFF)) * rstd * gv.x;
    hv.y = xv.y + bf2f((u16)(mb.x >> 16)) * rstd * gv.y;
    hv.z = xv.z + bf2f((u16)(mb.y & 0xFFFF)) * rstd * gv.z;
    hv.w = xv.w + bf2f((u16)(mb.y >> 16)) * rstd * gv.w;
    uint2 o;
    o.x = pk2(hv.x, hv.y);
    o.y = pk2(hv.z, hv.w);
    *(uint2*)(HB + i * 4) = o;
  }
}
__device__ __forceinline__ void phase8_out(const Params& p) {
  unsigned char* ws = p.ws;
  const uint2* HB = (const uint2*)(ws + WS_XN);
  const uint2* E = (const uint2*)(ws + WS_PROJ + (size_t)MTOK * 1024 * 2);
  const float* SS2 = (const float*)(ws + WS_SS2);
  const size_t gtid = (size_t)blockIdx.x * NTHR + threadIdx.x, gn = (size_t)gridDim.x * NTHR;
  for (size_t i = gtid; i < (size_t)MTOK * 256; i += gn) {
    int row = (int)(i >> 8), c4 = (int)(i & 255);
    float r2 = rsqrtf(SS2[row] * (1.f / 1024.f) + EPSV);
    uint2 hb = HB[i], eb = E[i];
    float4 g2 = ((const float4*)p.ple_norm)[c4];
    float4 hv;
    hv.x = bf2f((u16)(hb.x & 0xFFFF)) + bf2f((u16)(eb.x & 0xFFFF)) * r2 * g2.x;
    hv.y = bf2f((u16)(hb.x >> 16)) + bf2f((u16)(eb.x >> 16)) * r2 * g2.y;
    hv.z = bf2f((u16)(hb.y & 0xFFFF)) + bf2f((u16)(eb.y & 0xFFFF)) * r2 * g2.z;
    hv.w = bf2f((u16)(hb.y >> 16)) + bf2f((u16)(eb.y >> 16)) * r2 * g2.w;
    ((float4*)p.out)[i] = hv;
  }
}

#define XB_TMO 128
#define XB_XCNT(j) (256 + 64 * (j))
#define XB_XSUB(j) (1280 + 64 * (j))
#define XB_XGEN(j) (2304 + 64 * (j))
#define XB_TOP 3328
#define XB_TOPGEN 3392
#define XCD_BAR_WORDS 3456
#define XB_SPIN_CAP (1u << 18)
#define LAS __attribute__((address_space(3)))
__device__ __forceinline__ unsigned xb_ld(unsigned* p) { return __hip_atomic_load(p, __ATOMIC_RELAXED, __HIP_MEMORY_SCOPE_AGENT); }
__device__ __forceinline__ unsigned xb_add(unsigned* p, unsigned v) { return __hip_atomic_fetch_add(p, v, __ATOMIC_RELAXED, __HIP_MEMORY_SCOPE_AGENT); }
__device__ __forceinline__ unsigned xb_xcc_id() { return (unsigned)__builtin_amdgcn_s_getreg((3 << 11) | 20) & 0xFu; }
#define XB_SPIN(cond, bar)                                            \
  do {                                                                \
    unsigned _sp = 0;                                                 \
    while (cond) {                                                    \
      __builtin_amdgcn_s_sleep(1);                                    \
      if ((++_sp & 255u) == 0u) {                                     \
        if (xb_ld(&(bar)[XB_TMO])) break;                             \
        if (_sp > XB_SPIN_CAP) { atomicAdd(&(bar)[XB_TMO], 1u); break; } \
      }                                                               \
    }                                                                 \
  } while (0)
struct XcdBarrier {
  unsigned* bar;
  unsigned x;
  volatile LAS unsigned* st;
};
__device__ __forceinline__ XcdBarrier xcd_barrier_post(unsigned* bar, volatile LAS unsigned* st) {
  XcdBarrier b;
  b.bar = bar;
  b.x = xb_xcc_id();
  b.st = st;
  if (threadIdx.x == 0) (void)xb_add(&bar[XB_XCNT(b.x)], 1u);
  return b;
}
__device__ __forceinline__ void xcd_barrier_complete(unsigned* bar, unsigned x, unsigned& nloc, unsigned& nx) {
  const unsigned G = gridDim.x * gridDim.y * gridDim.z;
  unsigned sum, cnt, mine, sp = 0u;
  for (;;) {
    sum = 0u; cnt = 0u; mine = 0u;
#pragma unroll
    for (unsigned j = 0; j < 16; ++j) {
      const unsigned c = xb_ld(&bar[XB_XCNT(j)]);
      sum += c;
      cnt += (c > 0u) ? 1u : 0u;
      mine = (j == x) ? c : mine;
    }
    if (sum == G) break;
    __builtin_amdgcn_s_sleep(1);
    if ((++sp & 255u) == 0u) {
      if (xb_ld(&bar[XB_TMO])) break;
      if (sp > XB_SPIN_CAP) { atomicAdd(&bar[XB_TMO], 1u); break; }
    }
  }
  nloc = mine > 0u ? mine : 1u;
  nx = cnt > 0u ? cnt : 1u;
}
__device__ __forceinline__ void xcd_barrier(const XcdBarrier& b) {
  asm volatile("s_waitcnt vmcnt(0)" ::: "memory");
  __syncthreads();
  if (threadIdx.x == 0) {
    unsigned* bar = b.bar;
    __builtin_amdgcn_s_waitcnt(0);
    unsigned nloc = b.st[0], nx = b.st[1];
    if (nloc == 0u) {
      xcd_barrier_complete(bar, b.x, nloc, nx);
      b.st[0] = nloc;
      b.st[1] = nx;
    }
    const unsigned old = xb_add(&bar[XB_XSUB(b.x)], 1u);
    const unsigned gen = old / nloc;
    if (old + 1u == (gen + 1u) * nloc) {
      __builtin_amdgcn_fence(__ATOMIC_RELEASE, "agent");
      asm volatile("s_waitcnt vmcnt(0)" ::: "memory");
      const unsigned og = xb_add(&bar[XB_TOP], 1u);
      const unsigned tg = og / nx;
      if (og + 1u == (tg + 1u) * nx) xb_add(&bar[XB_TOPGEN], 1u);
      else XB_SPIN(xb_ld(&bar[XB_TOPGEN]) == tg, bar);
      __builtin_amdgcn_fence(__ATOMIC_ACQUIRE, "agent");
      xb_add(&bar[XB_XGEN(b.x)], 1u);
      asm volatile("s_waitcnt vmcnt(0)" ::: "memory");
    } else {
      XB_SPIN(xb_ld(&bar[XB_XGEN(b.x)]) == gen, bar);
      __builtin_amdgcn_fence(__ATOMIC_ACQUIRE, "agent");
      asm volatile("s_waitcnt vmcnt(0)" ::: "memory");
    }
  }
  __syncthreads();
}

#define NPHASE 9
#if !FUSED
__device__ __forceinline__ void run_phase(const Params& p, int ph) {
#ifdef ONLY_PHASE
  ph = ONLY_PHASE;
#endif
  switch (ph) {
    case 0: phase_prep(p); break;
    case 1: gemm_phase<0>(p); break;
    case 2: phase2_rope(p); phase2_vtrans(p); phase2_compress(p); phase2_gla1(p); break;
    case 3: phase3_scan(p); break;
    case 4: phase4_nsa(p); phase4_gla3(p); break;
    case 5: gemm_phase<1>(p); break;
    case 6: phase6_res(p); break;
    case 7: gemm_phase<2>(p); break;
    default: phase8_out(p); break;
  }
}
#endif

#ifndef DUP
#define DUP -1
#endif
constexpr int LDS_BYTES = 139264;
constexpr int LDS_BAR_OFF = LDS_BYTES - 16;
#define GSYNC() xcd_barrier(xb)
__global__ void __launch_bounds__(NTHR) mega_kernel(Params p) {
  cg::grid_group grid = cg::this_grid();
  volatile LAS unsigned* st = (volatile LAS unsigned*)(smem + LDS_BAR_OFF);
  if (threadIdx.x == 0) { st[0] = 0u; st[1] = 0u; }
  __syncthreads();
  XcdBarrier xb = xcd_barrier_post((unsigned*)(p.ws + WS_BAR), st);
  phase_prep(p);
  if (gridDim.x == 0x7FFFFFFFu) grid.sync();
  GSYNC();
  if (DUP == 0) { phase_prep(p); GSYNC(); }
  gemm_phase<0>(p);
  GSYNC();
  if (DUP == 1) { gemm_phase<0>(p); GSYNC(); }
  if (DUP == 20) { phase2_vtrans(p); GSYNC(); }
  if (DUP == 21) { phase2_compress(p); GSYNC(); }
  if (DUP == 22) { phase2_gla1(p); GSYNC(); }
  phase2_rope(p);
  phase2_vtrans(p);
#pragma unroll 1
  for (int st = 0; st < 2; ++st) {
    if ((st ^ (int)(blockIdx.x & 1)) == 0) phase2_compress(p);
    else phase2_gla1(p);
  }
  GSYNC();
  phase3_scan(p);
  GSYNC();
  if (DUP == 40) { phase4_nsa(p); GSYNC(); }
  if (DUP == 41) { phase4_gla3(p); GSYNC(); }
#pragma unroll 1
  for (int st = 0; st < 2; ++st) {
    if ((st ^ (int)(blockIdx.x & 1)) == 0) phase4_nsa(p);
    else phase4_gla3(p);
  }
  GSYNC();
  gemm_phase<1>(p);
  GSYNC();
  if (DUP == 6) { phase6_res(p); GSYNC(); }
  gemm_phase<2>(p);
  return;
  GSYNC();
  if (DUP == 99) { for (int i = 0; i < 8; ++i) GSYNC(); }
  if (DUP == 8) { phase8_out(p); GSYNC(); }
  phase8_out(p);
}
#if !FUSED
__global__ void __launch_bounds__(NTHR) phase_kernel(Params p, int ph) { run_phase(p, ph); }
#endif


extern "C" void kernel_launch(void* const* d_in, const int* in_sizes, int n_in, void* d_out, int out_size, void* d_ws,
                              size_t ws_size, hipStream_t stream) {
  static int grid_blocks = 0;
  if (!grid_blocks) {
    int dev = 0, cus = 0, per_cu = 0;
    hipGetDevice(&dev);
    hipDeviceGetAttribute(&cus, hipDeviceAttributeMultiprocessorCount, dev);
    hipFuncSetAttribute((const void*)mega_kernel, hipFuncAttributeMaxDynamicSharedMemorySize, LDS_BYTES);
#if !FUSED
    hipFuncSetAttribute((const void*)phase_kernel, hipFuncAttributeMaxDynamicSharedMemorySize, LDS_BYTES);
#endif
    hipOccupancyMaxActiveBlocksPerMultiprocessor(&per_cu, (const void*)mega_kernel, NTHR, LDS_BYTES);
    if (per_cu < 1) {
      fprintf(stderr, "occupancy query returned %d\n", per_cu);
      per_cu = 1;
    }
    if (per_cu > 1) per_cu = 1;
    grid_blocks = cus * per_cu;
    if (ws_size < WS_END2) fprintf(stderr, "workspace too small: %zu < %zu\n", ws_size, (size_t)WS_END2);
  }
  Params p{};
  p.x = (const float*)d_in[0];
  p.p = (const float*)d_in[1];
  p.pre_norm = (const float*)d_in[2];
  p.w_in = (const float*)d_in[3];
  p.a_up = (const float*)d_in[4];
  p.a_bias = (const float*)d_in[5];
  p.gnorm = (const float*)d_in[6];
  p.pos_k = (const float*)d_in[7];
  p.w1k = (const float*)d_in[8];
  p.w2k = (const float*)d_in[9];
  p.pos_v = (const float*)d_in[10];
  p.w1v = (const float*)d_in[11];
  p.w2v = (const float*)d_in[12];
  p.w_out = (const float*)d_in[13];
  p.post_norm = (const float*)d_in[14];
  p.ple_proj = (const float*)d_in[15];
  p.ple_gate = (const float*)d_in[16];
  p.ple_norm = (const float*)d_in[17];
  p.out = (float*)d_out;
  p.ws = (unsigned char*)d_ws;
#if FUSED
  hipMemsetAsync((char*)d_ws + WS_BAR, 0, 16384, stream);
  void* args[] = {&p};
  hipError_t e = hipLaunchCooperativeKernel((const void*)mega_kernel, dim3(grid_blocks), dim3(NTHR), args, LDS_BYTES, stream);
  if (e != hipSuccess) fprintf(stderr, "cooperative launch failed: %s (grid %d)\n", hipGetErrorString(e), grid_blocks);
#else
  for (int ph = 0; ph < NPHASE; ++ph) hipLaunchKernelGGL(phase_kernel, dim3(grid_blocks), dim3(NTHR), LDS_BYTES, stream, p, ph);
#endif
}
```

```cpp
#include <hip/hip_runtime.h>
#include <hip/hip_bf16.h>
#include <hip/hip_cooperative_groups.h>
#include <cstdio>
namespace cg = cooperative_groups;

#ifndef FUSED
#define FUSED 1
#endif

typedef unsigned short u16;
using bf16x8 = __attribute__((ext_vector_type(8))) short;
using f32x4 = __attribute__((ext_vector_type(4))) float;
using f32x16 = __attribute__((ext_vector_type(16))) float;
typedef __bf16 bf2_t __attribute__((ext_vector_type(2)));
typedef float f2_t __attribute__((ext_vector_type(2)));

#define NTHR 512
#define SEQ 8192
#define MTOK 16384
#define PP 3368
#define C_GQ 0
#define C_GK 256
#define C_GV 512
#define C_GA 1024
#define C_GZ 1040
#define C_NQ 1552
#define C_KC 2064
#define C_VC 2192
#define C_KS 2320
#define C_VS 2448
#define C_KW 2576
#define C_VW 2704
#define C_NG 2832
#define C_NZ 2856
#define EPSV 1e-6f
#define QSCALE_L2 0.18033688011112042f

constexpr size_t WS_XN = 0;
constexpr size_t WS_WTIN = WS_XN + (size_t)MTOK * 1024 * 2;
constexpr size_t WS_WTOUT = WS_WTIN + (size_t)3584 * 1024 * 2;
constexpr size_t WS_WTG = WS_WTOUT + (size_t)1024 * 1024 * 2;
constexpr size_t WS_WTP = WS_WTG + (size_t)1024 * 1024 * 2;
constexpr size_t WS_W1K = WS_WTP + (size_t)1024 * 256 * 2;
constexpr size_t WS_W1V = WS_W1K + (size_t)128 * 2048 * 2;
constexpr size_t WS_W2K = WS_W1V + (size_t)128 * 2048 * 2;
constexpr size_t WS_W2V = WS_W2K + (size_t)64 * 128 * 2;
constexpr size_t WS_PB = WS_W2V + (size_t)64 * 128 * 2;
constexpr size_t WS_ROPEC = WS_PB + (size_t)MTOK * 256 * 2;
constexpr size_t WS_ROPES = WS_ROPEC + (size_t)SEQ * 8 * 4;
constexpr size_t WS_SS1 = WS_ROPES + (size_t)SEQ * 8 * 4;
constexpr size_t WS_SS2 = WS_SS1 + (size_t)MTOK * 4;
constexpr size_t WS_PROJ = WS_SS2 + (size_t)MTOK * 4;
constexpr size_t WS_BCUM = WS_PROJ + (size_t)MTOK * PP * 2;
constexpr size_t WS_DS = WS_BCUM + (size_t)MTOK * 256 * 4;
constexpr size_t WS_DEC = WS_DS + (size_t)1024 * 8192 * 4;
constexpr size_t WS_KC = WS_DEC + (size_t)1024 * 64 * 4;
constexpr size_t WS_VCT = WS_KC + (size_t)4 * 512 * 64 * 2;
constexpr size_t WS_VST = WS_VCT + (size_t)4 * 512 * 64 * 2;
constexpr size_t WS_VWT = WS_VST + (size_t)4 * 64 * SEQ * 2;
constexpr size_t WS_BAR = WS_VWT + (size_t)4 * 64 * SEQ * 2;
constexpr size_t WS_END = WS_BAR + 16384;
constexpr size_t WS_E1 = WS_END;
constexpr size_t WS_END2 = WS_E1 + (size_t)MTOK * 1024 * 2;

struct Params {
  const float *x, *p, *pre_norm, *w_in, *a_up, *a_bias, *gnorm, *pos_k, *w1k, *w2k, *pos_v, *w1v, *w2v, *w_out, *post_norm,
      *ple_proj, *ple_gate, *ple_norm;
  float* out;
  unsigned char* ws;
};

extern __shared__ __attribute__((aligned(16))) unsigned char smem[];

__device__ __forceinline__ float bf2f(u16 h) { return __uint_as_float(((unsigned)h) << 16); }
__device__ __forceinline__ unsigned pk2(float a, float b) {
  f2_t v = {a, b};
  bf2_t r = __builtin_convertvector(v, bf2_t);
  return *(unsigned*)&r;
}
__device__ __forceinline__ u16 f2bf(float a) { return (u16)(pk2(a, 0.f) & 0xFFFFu); }
__device__ __forceinline__ float wave_sum(float v) {
  for (int o = 32; o > 0; o >>= 1) v += __shfl_xor(v, o);
  return v;
}
__device__ __forceinline__ float sigmoidf_(float x) { return __builtin_amdgcn_rcpf(1.f + __expf(-x)); }
__device__ __forceinline__ float siluf_(float x) { return x * __builtin_amdgcn_rcpf(1.f + __expf(-x)); }
__device__ __forceinline__ float ex2(float x) { return __builtin_amdgcn_exp2f(x); }
__device__ __forceinline__ float quad_sum(float v) {
  v += __int_as_float(__builtin_amdgcn_mov_dpp(__float_as_int(v), 0xB1, 0xF, 0xF, true));
  v += __int_as_float(__builtin_amdgcn_mov_dpp(__float_as_int(v), 0x4E, 0xF, 0xF, true));
  return v;
}
__device__ __forceinline__ f32x16 mfma32(bf16x8 a, bf16x8 b, f32x16 c) {
  return __builtin_amdgcn_mfma_f32_32x32x16_bf16(a, b, c, 0, 0, 0);
}
union U8 {
  bf16x8 v;
  uint4 u;
  uint2 h[2];
  u16 s[8];
};

constexpr int G_BK = 64, G_HALF = 128, G_HT = G_HALF * G_BK;
__device__ __forceinline__ int lds_byte(int r, int c) {
  int st = (r >> 4) * 2 + (c >> 5), rr = r & 15, cc = c & 31, ob = rr * 64 + cc * 2;
  return st * 1024 + (ob ^ (((ob >> 9) & 1) << 5));
}
__device__ __forceinline__ void stage_rc(int b, int& R, int& C) {
  int st = b / 1024, sb = b % 1024, swz = sb ^ (((sb >> 9) & 1) << 5);
  R = (st >> 1) * 16 + swz / 64;
  C = (st & 1) * 32 + (swz % 64) / 2;
}

template <int K, bool SWAP = false>
__device__ __forceinline__ void gemm256(const u16* __restrict__ A, const u16* __restrict__ Bt, const int brow,
                                        const int bcol, f32x4 (&acc)[2][2][4][2]) {
  u16* shm = (u16*)smem;
#define SA(b, h) (shm + ((b)*2 + (h)) * G_HT)
#define SB(b, h) (shm + (4 + (b)*2 + (h)) * G_HT)
#define STAGE(P, BASE, br, kt)                                                                                       \
  do {                                                                                                               \
    long _g = (long)(br)*K + (long)(kt)*G_BK;                                                                        \
    for (int _i = 0; _i < 2; ++_i) {                                                                                 \
      int _b = tidx * 16 + _i * 8192;                                                                                \
      int _r, _c;                                                                                                    \
      stage_rc(_b, _r, _c);                                                                                          \
      __builtin_amdgcn_global_load_lds((const unsigned*)(BASE + _g + (long)_r * K + _c), (unsigned*)((char*)(P) + _b), \
                                       16, 0, 0);                                                                    \
    }                                                                                                                \
  } while (0)
#define LDA(dst, b, h)                                                                                               \
  for (int m = 0; m < 4; ++m)                                                                                        \
    for (int k = 0; k < 2; ++k)                                                                                      \
  dst[m][k] = *reinterpret_cast<const bf16x8*>((char*)SA(b, h) + lds_byte(wr * 64 + m * 16 + fr, k * 32 + fq * 8))
#define LDB(dst, b, h)                                                                                               \
  for (int n = 0; n < 2; ++n)                                                                                        \
    for (int k = 0; k < 2; ++k)                                                                                      \
  dst[n][k] = *reinterpret_cast<const bf16x8*>((char*)SB(b, h) + lds_byte(wc * 32 + n * 16 + fr, k * 32 + fq * 8))
#define MMA(ai, bj, At, Bt_)                                                                                         \
  do {                                                                                                               \
    __builtin_amdgcn_s_setprio(1);                                                                                   \
    for (int m = 0; m < 4; ++m)                                                                                      \
      for (int n = 0; n < 2; ++n)                                                                                    \
        for (int k = 0; k < 2; ++k)                                                                                  \
          acc[ai][bj][m][n] = SWAP ? __builtin_amdgcn_mfma_f32_16x16x32_bf16(Bt_[n][k], At[m][k], acc[ai][bj][m][n], 0, 0, 0) \
                                   : __builtin_amdgcn_mfma_f32_16x16x32_bf16(At[m][k], Bt_[n][k], acc[ai][bj][m][n], 0, 0, 0); \
    __builtin_amdgcn_s_setprio(0);                                                                                   \
  } while (0)
#define WAIT_V(n) asm volatile("s_waitcnt vmcnt(" #n ")" ::: "memory")
#define WAIT_L(n) asm volatile("s_waitcnt lgkmcnt(" #n ")" ::: "memory")
#define BAR __builtin_amdgcn_s_barrier()
#define SCHED __builtin_amdgcn_sched_barrier(0)
  int tidx = threadIdx.x;
  asm volatile("" : "+v"(tidx));
  const int wid = tidx >> 6, lane = tidx & 63, wr = wid >> 2, wc = wid & 3, fr = lane & 15, fq = lane >> 4;
#pragma unroll
  for (int a = 0; a < 2; ++a)
#pragma unroll
    for (int b = 0; b < 2; ++b)
#pragma unroll
      for (int m = 0; m < 4; ++m)
#pragma unroll
        for (int n = 0; n < 2; ++n) acc[a][b][m][n] = f32x4{0.f, 0.f, 0.f, 0.f};
  bf16x8 At[4][2], B0[2][2], B1[2][2];
  const int nt = K / G_BK;
  STAGE(SB(0, 0), Bt, bcol, 0);
  STAGE(SA(0, 0), A, brow, 0);
  STAGE(SB(0, 1), Bt, bcol + G_HALF, 0);
  STAGE(SA(0, 1), A, brow + G_HALF, 0);
  if (wr == 1) BAR;
  WAIT_V(4);
  BAR;
  STAGE(SB(1, 0), Bt, bcol, 1);
  STAGE(SA(1, 0), A, brow, 1);
  STAGE(SB(1, 1), Bt, bcol + G_HALF, 1);
  WAIT_V(6);
  BAR;
  for (int t = 0; t < nt - 2; t += 2) {
    LDB(B0, 0, 0); SCHED; LDA(At, 0, 0); STAGE(SA(1, 1), A, brow + G_HALF, t + 1);
    WAIT_L(8); BAR; WAIT_L(0); MMA(0, 0, At, B0); BAR; SCHED;
    LDB(B1, 0, 1); STAGE(SB(0, 0), Bt, bcol, t + 2);
    BAR; WAIT_L(0); MMA(0, 1, At, B1); BAR;
    LDA(At, 0, 1); STAGE(SA(0, 0), A, brow, t + 2);
    BAR; WAIT_L(0); MMA(1, 0, At, B0); BAR; SCHED;
    STAGE(SB(0, 1), Bt, bcol + G_HALF, t + 2);
    WAIT_V(6); BAR; MMA(1, 1, At, B1); BAR;
    LDB(B0, 1, 0); SCHED; LDA(At, 1, 0); STAGE(SA(0, 1), A, brow + G_HALF, t + 2);
    WAIT_L(8); BAR; WAIT_L(0); MMA(0, 0, At, B0); BAR; SCHED;
    LDB(B1, 1, 1); STAGE(SB(1, 0), Bt, bcol, t + 3);
    BAR; WAIT_L(0); MMA(0, 1, At, B1); BAR;
    LDA(At, 1, 1); STAGE(SA(1, 0), A, brow, t + 3);
    BAR; WAIT_L(0); MMA(1, 0, At, B0); BAR; SCHED;
    STAGE(SB(1, 1), Bt, bcol + G_HALF, t + 3);
    WAIT_V(6); BAR; MMA(1, 1, At, B1); BAR;
  }
  {
    LDB(B0, 0, 0); LDA(At, 0, 0); STAGE(SA(1, 1), A, brow + G_HALF, nt - 1);
    BAR; WAIT_L(0); MMA(0, 0, At, B0); BAR;
    LDB(B1, 0, 1); BAR; WAIT_L(0); MMA(0, 1, At, B1); BAR;
    LDA(At, 0, 1); WAIT_V(4); BAR; WAIT_L(0); MMA(1, 0, At, B0); MMA(1, 1, At, B1); BAR;
  }
  {
    LDB(B0, 1, 0); LDA(At, 1, 0); WAIT_V(2); BAR; WAIT_L(0); MMA(0, 0, At, B0); BAR;
    LDB(B1, 1, 1); WAIT_V(0); BAR; WAIT_L(0); MMA(0, 1, At, B1); BAR;
    LDA(At, 1, 1); BAR; WAIT_L(0); MMA(1, 0, At, B0); MMA(1, 1, At, B1); BAR;
  }
  if (wr == 0) BAR;
#undef SA
#undef SB
#undef STAGE
#undef LDA
#undef LDB
#undef MMA
}

__device__ __forceinline__ void tile_map(int wgid, int nM, int nN, int& pm, int& pn) {
  const int NX = 8, WGM = 8;
  int nwg = nM * nN;
  {
    int q = nwg / NX, r = nwg % NX, xcd = wgid % NX, off = wgid / NX;
    wgid = (xcd < r ? xcd * (q + 1) : r * (q + 1) + (xcd - r) * q) + off;
  }
  int nig = WGM * nN, gid = wgid / nig, fm = gid * WGM, gsz = min(nM - fm, WGM);
  pm = fm + ((wgid % nig) % gsz);
  pn = (wgid % nig) / gsz;
}

__device__ __forceinline__ void e1_tile(unsigned char* ws, int t2, f32x4 (&acc)[2][2][4][2]) {
  int pm, pn;
  tile_map(t2, 64, 4, pm, pn);
  const int brow = pm * 256, bcol = pn * 256;
  gemm256<256, true>((const u16*)(ws + WS_PB), (const u16*)(ws + WS_WTP), brow, bcol, acc);
  int tide = threadIdx.x;
  asm volatile("" : "+v"(tide));
  const int wid = tide >> 6, lane = tide & 63, wr = wid >> 2, wc = wid & 3, fr = lane & 15, fq = lane >> 4;
  u16* E1 = (u16*)(ws + WS_E1);
#pragma unroll
  for (int ai = 0; ai < 2; ++ai)
#pragma unroll
    for (int m = 0; m < 4; ++m) {
      const int row = brow + ai * 128 + wr * 64 + m * 16 + fr;
#pragma unroll
      for (int bj = 0; bj < 2; ++bj)
#pragma unroll
        for (int n = 0; n < 2; ++n) {
          const int col0 = bcol + bj * 128 + wc * 32 + n * 16 + fq * 4;
          uint2 o;
          o.x = pk2(acc[ai][bj][m][n][0], acc[ai][bj][m][n][1]);
          o.y = pk2(acc[ai][bj][m][n][2], acc[ai][bj][m][n][3]);
          *(uint2*)(E1 + (size_t)row * 1024 + col0) = o;
        }
    }
  asm volatile("s_waitcnt vmcnt(0)" ::: "memory");
  __syncthreads();
}

template <int EPI>
__device__ __forceinline__ void gemm_phase(const Params& p) {
  unsigned char* ws = p.ws;
  const int nM = 64, nN = (EPI == 0) ? 14 : 4;
  f32x4 acc[2][2][4][2];
  for (int t = blockIdx.x; t < nM * nN; t += gridDim.x) {
    int tide = threadIdx.x;
    asm volatile("" : "+v"(tide));
    const int wid = tide >> 6, lane = tide & 63, wr = wid >> 2, wc = wid & 3, fr = lane & 15, fq = lane >> 4;
    int pm, pn;
    tile_map(t, nM, nN, pm, pn);
    const int brow = pm * 256, bcol = pn * 256;
    if (EPI == 0) {
      gemm256<1024>((const u16*)(ws + WS_XN), (const u16*)(ws + WS_WTIN), brow, bcol, acc);
      u16* PJ = (u16*)(ws + WS_PROJ);
#pragma unroll
      for (int ai = 0; ai < 2; ++ai)
#pragma unroll
        for (int bj = 0; bj < 2; ++bj)
#pragma unroll
          for (int m = 0; m < 4; ++m)
#pragma unroll
            for (int n = 0; n < 2; ++n) {
              int col = bcol + bj * 128 + wc * 32 + n * 16 + fr;
              if (col < PP) {
#pragma unroll
                for (int j = 0; j < 4; ++j) {
                  int row = brow + ai * 128 + wr * 64 + m * 16 + fq * 4 + j;
                  PJ[(size_t)row * PP + col] = f2bf(acc[ai][bj][m][n][j]);
                }
              }
            }
    } else if (EPI == 1) {
      gemm256<1024, true>((const u16*)(ws + WS_XN), (const u16*)(ws + WS_WTOUT), brow, bcol, acc);
      float* SS = (float*)(ws + WS_SS1);
#pragma unroll
      for (int ai = 0; ai < 2; ++ai)
#pragma unroll
        for (int m = 0; m < 4; ++m) {
          const int row = brow + ai * 128 + wr * 64 + m * 16 + fr;
          float ss = 0.f;
#pragma unroll
          for (int bj = 0; bj < 2; ++bj)
#pragma unroll
            for (int n = 0; n < 2; ++n)
#pragma unroll
              for (int j = 0; j < 4; ++j) ss += acc[ai][bj][m][n][j] * acc[ai][bj][m][n][j];
          ss += __shfl_xor(ss, 16);
          ss += __shfl_xor(ss, 32);
          if (fq == 0) atomicAdd(&SS[row], ss);
        }
      {
        unsigned* cnt = (unsigned*)(ws + WS_BAR) + 3584 + pm * 8 + 4;
        asm volatile("s_waitcnt vmcnt(0)" ::: "memory");
        __syncthreads();
        if (threadIdx.x == 0) {
          __builtin_amdgcn_fence(__ATOMIC_RELEASE, "agent");
          asm volatile("s_waitcnt vmcnt(0)" ::: "memory");
          __hip_atomic_fetch_add(cnt, 1u, __ATOMIC_RELAXED, __HIP_MEMORY_SCOPE_AGENT);
          unsigned sp = 0;
          while (__hip_atomic_load(cnt, __ATOMIC_RELAXED, __HIP_MEMORY_SCOPE_AGENT) < 4u) {
            __builtin_amdgcn_s_sleep(1);
            if (++sp > (1u << 22)) break;
          }
          __builtin_amdgcn_fence(__ATOMIC_ACQUIRE, "agent");
          asm volatile("s_waitcnt vmcnt(0)" ::: "memory");
        }
        __syncthreads();
        int tide4 = threadIdx.x;
        asm volatile("" : "+v"(tide4));
        const int wid4 = tide4 >> 6, lane4 = tide4 & 63, wr4 = wid4 >> 2, wc4 = wid4 & 3, fr4 = lane4 & 15, fq4 = lane4 >> 4;
        u16* HB = (u16*)(ws + WS_XN);
#pragma unroll
        for (int ai = 0; ai < 2; ++ai)
#pragma unroll
          for (int m = 0; m < 4; ++m) {
            const int row = brow + ai * 128 + wr4 * 64 + m * 16 + fr4;
            const float r1 = rsqrtf(__hip_atomic_load(&SS[row], __ATOMIC_RELAXED, __HIP_MEMORY_SCOPE_AGENT) * (1.f / 1024.f) + EPSV);
#pragma unroll
            for (int bj = 0; bj < 2; ++bj)
#pragma unroll
              for (int n = 0; n < 2; ++n) {
                const int col0 = bcol + bj * 128 + wc4 * 32 + n * 16 + fq4 * 4;
                const size_t idx = (size_t)row * 1024 + col0;
                const float4 xv = *(const float4*)(p.x + idx);
                const float4 gv = *(const float4*)(p.post_norm + col0);
                uint2 o;
                o.x = pk2(xv.x + acc[ai][bj][m][n][0] * r1 * gv.x, xv.y + acc[ai][bj][m][n][1] * r1 * gv.y);
                o.y = pk2(xv.z + acc[ai][bj][m][n][2] * r1 * gv.z, xv.w + acc[ai][bj][m][n][3] * r1 * gv.w);
                *(uint2*)(HB + idx) = o;
              }
            asm volatile("" ::: "memory");
          }
      }
    } else {
      const u16* E = (const u16*)(ws + WS_E1);
      float* SS = (float*)(ws + WS_SS2);
      gemm256<1024, true>((const u16*)(ws + WS_XN), (const u16*)(ws + WS_WTG), brow, bcol, acc);
      int tide2 = threadIdx.x;
      asm volatile("" : "+v"(tide2));
      const int wid2 = tide2 >> 6, lane2 = tide2 & 63, wr2 = wid2 >> 2, wc2 = wid2 & 3, fr2 = lane2 & 15, fq2 = lane2 >> 4;
#pragma unroll
      for (int ai = 0; ai < 2; ++ai)
#pragma unroll
        for (int m = 0; m < 4; ++m) {
          const int row = brow + ai * 128 + wr2 * 64 + m * 16 + fr2;
          float ss = 0.f;
#pragma unroll
          for (int bj = 0; bj < 2; ++bj)
#pragma unroll
            for (int n = 0; n < 2; ++n) {
              const int col0 = bcol + bj * 128 + wc2 * 32 + n * 16 + fq2 * 4;
              const uint2 eb = *(const uint2*)(E + (size_t)row * 1024 + col0);
              const float e0 = bf2f((u16)(eb.x & 0xFFFF)), e1 = bf2f((u16)(eb.x >> 16)), e2 = bf2f((u16)(eb.y & 0xFFFF)), e3 = bf2f((u16)(eb.y >> 16));
              const float v0 = e0 * sigmoidf_(acc[ai][bj][m][n][0]), v1 = e1 * sigmoidf_(acc[ai][bj][m][n][1]);
              const float v2 = e2 * sigmoidf_(acc[ai][bj][m][n][2]), v3 = e3 * sigmoidf_(acc[ai][bj][m][n][3]);
              acc[ai][bj][m][n][0] = v0; acc[ai][bj][m][n][1] = v1; acc[ai][bj][m][n][2] = v2; acc[ai][bj][m][n][3] = v3;
              ss += (v0 * v0 + v1 * v1) + (v2 * v2 + v3 * v3);
            }
          asm volatile("" ::: "memory");
          ss += __shfl_xor(ss, 16);
          ss += __shfl_xor(ss, 32);
          if (fq2 == 0) atomicAdd(&SS[row], ss);
        }
      {
        unsigned* cnt = (unsigned*)(ws + WS_BAR) + 3584 + pm * 8;
        asm volatile("s_waitcnt vmcnt(0)" ::: "memory");
        __syncthreads();
        if (threadIdx.x == 0) {
          __builtin_amdgcn_fence(__ATOMIC_RELEASE, "agent");
          asm volatile("s_waitcnt vmcnt(0)" ::: "memory");
          __hip_atomic_fetch_add(cnt, 1u, __ATOMIC_RELAXED, __HIP_MEMORY_SCOPE_AGENT);
          unsigned sp = 0;
          while (__hip_atomic_load(cnt, __ATOMIC_RELAXED, __HIP_MEMORY_SCOPE_AGENT) < 4u) {
            __builtin_amdgcn_s_sleep(1);
            if (++sp > (1u << 22)) break;
          }
          __builtin_amdgcn_fence(__ATOMIC_ACQUIRE, "agent");
          asm volatile("s_waitcnt vmcnt(0)" ::: "memory");
        }
        __syncthreads();
        int tide4 = threadIdx.x;
        asm volatile("" : "+v"(tide4));
        const int wid4 = tide4 >> 6, lane4 = tide4 & 63, wr4 = wid4 >> 2, wc4 = wid4 & 3, fr4 = lane4 & 15, fq4 = lane4 >> 4;
        const u16* HB = (const u16*)(ws + WS_XN);
#pragma unroll
        for (int ai = 0; ai < 2; ++ai)
#pragma unroll
          for (int m = 0; m < 4; ++m) {
            const int row = brow + ai * 128 + wr4 * 64 + m * 16 + fr4;
            const float r2 = rsqrtf(__hip_atomic_load(&SS[row], __ATOMIC_RELAXED, __HIP_MEMORY_SCOPE_AGENT) * (1.f / 1024.f) + EPSV);
#pragma unroll
            for (int bj = 0; bj < 2; ++bj)
#pragma unroll
              for (int n = 0; n < 2; ++n) {
                const int col0 = bcol + bj * 128 + wc4 * 32 + n * 16 + fq4 * 4;
                const size_t idx = (size_t)row * 1024 + col0;
                const uint2 hb = *(const uint2*)(HB + idx);
                const float4 gv = *(const float4*)(p.ple_norm + col0);
                float4 o;
                o.x = bf2f((u16)(hb.x & 0xFFFF)) + acc[ai][bj][m][n][0] * r2 * gv.x;
                o.y = bf2f((u16)(hb.x >> 16)) + acc[ai][bj][m][n][1] * r2 * gv.y;
                o.z = bf2f((u16)(hb.y & 0xFFFF)) + acc[ai][bj][m][n][2] * r2 * gv.z;
                o.w = bf2f((u16)(hb.y >> 16)) + acc[ai][bj][m][n][3] * r2 * gv.w;
                *(float4*)(p.out + idx) = o;
              }
            asm volatile("" ::: "memory");
          }
      }
    }
    asm volatile("s_waitcnt vmcnt(0)" ::: "memory");
    __syncthreads();
  }
  if (EPI == 0) {
    const int G = (int)gridDim.x, rem = (nM * nN) % G;
    const int first = rem, nE = G - rem;
    const int me = (int)blockIdx.x - first;
    if (me >= 0)
      for (int t2 = me; t2 < 256; t2 += nE) e1_tile(ws, t2, acc);
  }
}

__device__ __forceinline__ void transpose_tile(const float* __restrict__ src, int R, int C, u16* __restrict__ dst, int tr, int tc) {
  float* tile = (float*)smem;
  const int tid = threadIdx.x;
  const int r0 = tr * 64, c0 = tc * 64;
  {
    int cc = tid & 63, rr = tid >> 6;
#pragma unroll
    for (int i = 0; i < 8; ++i) {
      int r = rr + 8 * i;
      float v = 0.f;
      if (c0 + cc < C) v = src[(size_t)(r0 + r) * C + c0 + cc];
      tile[r * 65 + cc] = v;
    }
  }
  __syncthreads();
  {
    int rr = tid & 63, cc = tid >> 6;
#pragma unroll
    for (int i = 0; i < 8; ++i) {
      int c = cc + 8 * i;
      dst[(size_t)(c0 + c) * R + r0 + rr] = f2bf(tile[rr * 65 + c]);
    }
  }
  __syncthreads();
}

__device__ __forceinline__ void phase_prep(const Params& p) {
  unsigned char* ws = p.ws;
  const int tid = threadIdx.x, lane = tid & 63, wave = tid >> 6;
  const int nblk = gridDim.x, bid = blockIdx.x;
  const size_t gtid = (size_t)bid * NTHR + tid, gn = (size_t)nblk * NTHR;
  {
    u16* XN = (u16*)(ws + WS_XN);
    float4 g4[4];
#pragma unroll
    for (int i = 0; i < 4; ++i) g4[i] = ((const float4*)p.pre_norm)[lane + 64 * i];
    for (int row0 = (bid * 8 + wave) * 4; row0 < MTOK; row0 += nblk * 8 * 4) {
      float4 v[4][4];
      float ss[4];
#pragma unroll
      for (int q = 0; q < 4; ++q) {
        const float4* xr = (const float4*)(p.x + (size_t)(row0 + q) * 1024);
#pragma unroll
        for (int i = 0; i < 4; ++i) v[q][i] = xr[lane + 64 * i];
      }
#pragma unroll
      for (int q = 0; q < 4; ++q) {
        float s = 0.f;
#pragma unroll
        for (int i = 0; i < 4; ++i) s += v[q][i].x * v[q][i].x + v[q][i].y * v[q][i].y + v[q][i].z * v[q][i].z + v[q][i].w * v[q][i].w;
        ss[q] = s;
      }
#pragma unroll
      for (int o = 32; o > 0; o >>= 1) {
#pragma unroll
        for (int q = 0; q < 4; ++q) ss[q] += __shfl_xor(ss[q], o);
      }
#pragma unroll
      for (int q = 0; q < 4; ++q) {
        float r = rsqrtf(ss[q] * (1.f / 1024.f) + EPSV);
#pragma unroll
        for (int i = 0; i < 4; ++i) {
          uint2 o;
          o.x = pk2(v[q][i].x * r * g4[i].x, v[q][i].y * r * g4[i].y);
          o.y = pk2(v[q][i].z * r * g4[i].z, v[q][i].w * r * g4[i].w);
          *(uint2*)(XN + (size_t)(row0 + q) * 1024 + (lane + 64 * i) * 4) = o;
        }
      }
    }
  }
  {
    u16* PB = (u16*)(ws + WS_PB);
    const float4* ps = (const float4*)p.p;
    for (size_t i = gtid; i < (size_t)MTOK * 256 / 4; i += gn) {
      float4 v = ps[i];
      uint2 o;
      o.x = pk2(v.x, v.y);
      o.y = pk2(v.z, v.w);
      *(uint2*)(PB + i * 4) = o;
    }
  }
  {
    float* RC = (float*)(ws + WS_ROPEC);
    float* RS = (float*)(ws + WS_ROPES);
    float* SS = (float*)(ws + WS_SS1);
    for (size_t i = gtid; i < (size_t)SEQ * 8; i += gn) {
      int pos = (int)(i >> 3), fi = (int)(i & 7);
      float inv = fi == 0   ? 1.0f
                  : fi == 1 ? 0.1939227432012558f
                  : fi == 2 ? 0.03760603070259094f
                  : fi == 3 ? 0.007292664609849453f
                  : fi == 4 ? 0.0014142135623842478f
                  : fi == 5 ? 0.00027424818836152554f
                  : fi == 6 ? 5.318296098266728e-05f
                            : 1.0313386155758053e-05f;
      float ang = (float)pos * inv;
      double rev = (double)ang * 0.15915494309189535;
      rev -= floor(rev);
      float fr = (float)rev;
      RC[i] = __builtin_amdgcn_cosf(fr);
      RS[i] = __builtin_amdgcn_sinf(fr);
    }
    for (size_t i = gtid; i < (size_t)MTOK * 2; i += gn) SS[i] = 0.f;
  }
  {
    const int n_in = 16 * 56, n_out = 256, n_g = 256, n_p = 4 * 16, n_w1 = 32 * 2, n_w2 = 2;
    const int total = n_in + n_out + n_g + n_p + 2 * n_w1 + 2 * n_w2;
    for (int t = bid; t < total; t += nblk) {
      int u = t;
      const float* src;
      u16* dst;
      int R, C, tr, tc;
      if (u < n_in) { src = p.w_in; R = 1024; C = PP; dst = (u16*)(ws + WS_WTIN); tr = u / 56; tc = u % 56; }
      else if ((u -= n_in) < n_out) { src = p.w_out; R = 1024; C = 1024; dst = (u16*)(ws + WS_WTOUT); tr = u / 16; tc = u % 16; }
      else if ((u -= n_out) < n_g) { src = p.ple_gate; R = 1024; C = 1024; dst = (u16*)(ws + WS_WTG); tr = u / 16; tc = u % 16; }
      else if ((u -= n_g) < n_p) { src = p.ple_proj; R = 256; C = 1024; dst = (u16*)(ws + WS_WTP); tr = u / 16; tc = u % 16; }
      else if ((u -= n_p) < n_w1) { src = p.w1k; R = 2048; C = 128; dst = (u16*)(ws + WS_W1K); tr = u / 2; tc = u % 2; }
      else if ((u -= n_w1) < n_w1) { src = p.w1v; R = 2048; C = 128; dst = (u16*)(ws + WS_W1V); tr = u / 2; tc = u % 2; }
      else if ((u -= n_w1) < n_w2) { src = p.w2k; R = 128; C = 64; dst = (u16*)(ws + WS_W2K); tr = u; tc = 0; }
      else { u -= n_w2; src = p.w2v; R = 128; C = 64; dst = (u16*)(ws + WS_W2V); tr = u; tc = 0; }
      transpose_tile(src, R, C, dst, tr, tc);
    }
  }
}

__device__ __forceinline__ void phase2_rope(const Params& p) {
  unsigned char* ws = p.ws;
  u16* PJ = (u16*)(ws + WS_PROJ);
  const float* RC = (const float*)(ws + WS_ROPEC);
  const float* RS = (const float*)(ws + WS_ROPES);
  const size_t gtid = (size_t)blockIdx.x * NTHR + threadIdx.x, gn = (size_t)gridDim.x * NTHR;
  for (size_t i = gtid; i < (size_t)MTOK * 12; i += gn) {
    int tok = (int)(i / 12), slot = (int)(i % 12);
    int col = slot < 8 ? C_NQ + slot * 64 : (slot < 10 ? C_KS + (slot - 8) * 64 : C_KW + (slot - 10) * 64);
    int pos = tok & (SEQ - 1);
    u16* ptr = PJ + (size_t)tok * PP + col;
    U8 a, b, oa, ob;
    a.u = *(const uint4*)ptr;
    b.u = *(const uint4*)(ptr + 8);
    float4 c0 = *(const float4*)(RC + pos * 8), c1 = *(const float4*)(RC + pos * 8 + 4);
    float4 s0 = *(const float4*)(RS + pos * 8), s1 = *(const float4*)(RS + pos * 8 + 4);
    float cs[8] = {c0.x, c0.y, c0.z, c0.w, c1.x, c1.y, c1.z, c1.w};
    float sn[8] = {s0.x, s0.y, s0.z, s0.w, s1.x, s1.y, s1.z, s1.w};
#pragma unroll
    for (int k = 0; k < 8; ++k) {
      float x1 = bf2f(a.s[k]), x2 = bf2f(b.s[k]);
      oa.s[k] = f2bf(x1 * cs[k] - x2 * sn[k]);
      ob.s[k] = f2bf(x2 * cs[k] + x1 * sn[k]);
    }
    *(uint4*)ptr = oa.u;
    *(uint4*)(ptr + 8) = ob.u;
  }
}

__device__ __forceinline__ void phase2_vtrans(const Params& p) {
  unsigned char* ws = p.ws;
  const u16* PJ = (const u16*)(ws + WS_PROJ);
  u16* T = (u16*)smem;
  const int tid = threadIdx.x;
  for (int it = blockIdx.x; it < 1024; it += gridDim.x) {
    int which = it >> 9, b = (it >> 8) & 1, h = (it >> 7) & 1, tile = it & 127;
    int col0 = (which ? C_VW : C_VS) + h * 64;
    u16* dst = (u16*)(ws + (which ? WS_VWT : WS_VST));
    {
      int row = tid >> 3, ch = tid & 7;
      uint4 v = *(const uint4*)(PJ + (size_t)(b * SEQ + tile * 64 + row) * PP + col0 + ch * 8);
      *(uint4*)(T + row * 72 + ch * 8) = v;
    }
    __syncthreads();
    {
      int d = tid >> 3, tc = tid & 7;
      U8 o;
#pragma unroll
      for (int i = 0; i < 8; ++i) o.s[i] = T[(tc * 8 + i) * 72 + d];
      *(uint4*)(dst + ((size_t)(b * 2 + h) * 64 + d) * SEQ + tile * 64 + tc * 8) = o.u;
    }
    __syncthreads();
  }
}

__device__ __forceinline__ void phase2_compress(const Params& p) {
  unsigned char* ws = p.ws;
  const u16* PJ = (const u16*)(ws + WS_PROJ);
  const float* RC = (const float*)(ws + WS_ROPEC);
  const float* RS = (const float*)(ws + WS_ROPES);
  constexpr int AST = 2064;
  u16* AL = (u16*)smem;
  u16* H = (u16*)(smem + 16 * AST * 2);
  float* OF = (float*)(smem + 16 * AST * 2 + 16 * 136 * 2);
  const int tid = threadIdx.x, lane = tid & 63, w = tid >> 6, fr = lane & 15, fq = lane >> 4;
  for (int it = blockIdx.x; it < 256; it += gridDim.x) {
    int which = it >> 7, b = (it >> 6) & 1, h = (it >> 5) & 1, ct = it & 31;
    const int c0 = ct * 16;
    const int colbase = (which ? C_VC : C_KC) + h * 64;
    const float* pos = which ? p.pos_v : p.pos_k;
    const u16* W1 = (const u16*)(ws + (which ? WS_W1V : WS_W1K));
    const u16* W2 = (const u16*)(ws + (which ? WS_W2V : WS_W2K));
    const int n0 = w * 16;
    const u16* wrow = W1 + (size_t)(n0 + fr) * 2048 + fq * 8;
    U8 wbuf[2][16];
#pragma unroll
    for (int i = 0; i < 16; ++i) wbuf[0][i].u = *(const uint4*)(wrow + i * 32);
    {
      U8 xq[5];
#pragma unroll
      for (int q = 0; q < 5; ++q) {
        int u = tid + q * NTHR;
        u = u < 272 * 8 ? u : 272 * 8 - 1;
        int tok = c0 * 16 + (u >> 3);
        tok = tok > SEQ - 1 ? SEQ - 1 : tok;
        xq[q].u = *(const uint4*)(PJ + (size_t)(b * SEQ + tok) * PP + colbase + (u & 7) * 8);
      }
#pragma unroll
      for (int q = 0; q < 5; ++q) {
        const int u = tid + q * NTHR;
        if (u < 272 * 8) {
          const int tl = u >> 3, ch = u & 7;
          const int cl = tl >> 4, l = tl & 15;
          float xv[8];
#pragma unroll
          for (int k = 0; k < 8; ++k) xv[k] = bf2f(xq[q].s[k]);
          if (cl <= 15) {
            float4 p0 = *(const float4*)(pos + l * 64 + ch * 8), p1 = *(const float4*)(pos + l * 64 + ch * 8 + 4);
            uint4 o;
            o.x = pk2(xv[0] + p0.x, xv[1] + p0.y);
            o.y = pk2(xv[2] + p0.z, xv[3] + p0.w);
            o.z = pk2(xv[4] + p1.x, xv[5] + p1.y);
            o.w = pk2(xv[6] + p1.z, xv[7] + p1.w);
            *(uint4*)(AL + cl * AST + l * 64 + ch * 8) = o;
          }
          if (cl >= 1) {
            int l2 = l + 16;
            float4 p0 = *(const float4*)(pos + l2 * 64 + ch * 8), p1 = *(const float4*)(pos + l2 * 64 + ch * 8 + 4);
            uint4 o;
            o.x = pk2(xv[0] + p0.x, xv[1] + p0.y);
            o.y = pk2(xv[2] + p0.z, xv[3] + p0.w);
            o.z = pk2(xv[4] + p1.x, xv[5] + p1.y);
            o.w = pk2(xv[6] + p1.z, xv[7] + p1.w);
            *(uint4*)(AL + (cl - 1) * AST + l2 * 64 + ch * 8) = o;
          }
        }
      }
    }
    __syncthreads();
    f32x4 acc = {0.f, 0.f, 0.f, 0.f};
    const u16* arow = AL + fr * AST + fq * 8;
#pragma unroll
    for (int bt = 0; bt < 4; ++bt) {
      if (bt + 1 < 4) {
#pragma unroll
        for (int i = 0; i < 16; ++i) wbuf[(bt + 1) & 1][i].u = *(const uint4*)(wrow + ((bt + 1) * 16 + i) * 32);
      }
#pragma unroll
      for (int i = 0; i < 16; ++i) {
        U8 aa;
        aa.u = *(const uint4*)(arow + (bt * 16 + i) * 32);
        acc = __builtin_amdgcn_mfma_f32_16x16x32_bf16(aa.v, wbuf[bt & 1][i].v, acc, 0, 0, 0);
      }
    }
#pragma unroll
    for (int j = 0; j < 4; ++j) H[(fq * 4 + j) * 136 + n0 + fr] = f2bf(siluf_(acc[j]));
    __syncthreads();
    if (w < 4) {
      f32x4 a2 = {0.f, 0.f, 0.f, 0.f};
#pragma unroll
      for (int ks = 0; ks < 4; ++ks) {
        U8 ha, wb;
        ha.u = *(const uint4*)(H + fr * 136 + ks * 32 + fq * 8);
        wb.u = *(const uint4*)(W2 + (size_t)(w * 16 + fr) * 128 + ks * 32 + fq * 8);
        a2 = __builtin_amdgcn_mfma_f32_16x16x32_bf16(ha.v, wb.v, a2, 0, 0, 0);
      }
#pragma unroll
      for (int j = 0; j < 4; ++j) OF[(fq * 4 + j) * 64 + w * 16 + fr] = a2[j];
    }
    __syncthreads();
    {
      int cl = tid >> 5, dd = tid & 31;
      int c = c0 + cl;
      float v0 = OF[cl * 64 + dd], v1 = OF[cl * 64 + dd + 32];
      if (which == 0) {
        if (dd < 16) {
          int partner = dd < 8 ? dd + 8 : dd - 8;
          float y = OF[cl * 64 + partner];
          int ps = c * 16 + 31;
          ps = ps > SEQ - 1 ? SEQ - 1 : ps;
          float cs = RC[ps * 8 + (dd & 7)], sn = RS[ps * 8 + (dd & 7)];
          v0 = dd < 8 ? v0 * cs - y * sn : v0 * cs + y * sn;
        }
        u16* KC = (u16*)(ws + WS_KC);
        KC[((size_t)(b * 2 + h) * 512 + c) * 64 + dd] = f2bf(v0);
        KC[((size_t)(b * 2 + h) * 512 + c) * 64 + dd + 32] = f2bf(v1);
      } else {
        u16* VCT = (u16*)(ws + WS_VCT);
        VCT[((size_t)(b * 2 + h) * 64 + dd) * 512 + c] = f2bf(v0);
        VCT[((size_t)(b * 2 + h) * 64 + dd + 32) * 512 + c] = f2bf(v1);
      }
    }
    __syncthreads();
  }
}

__device__ __forceinline__ float logsig(float u) { return fminf(u, 0.f) - __logf(1.f + __expf(-fabsf(u))); }

__device__ __forceinline__ void phase2_gla1(const Params& p) {
  unsigned char* ws = p.ws;
  const u16* PJ = (const u16*)(ws + WS_PROJ);
  float* BC = (float*)(ws + WS_BCUM);
  u16* DS = (u16*)(ws + WS_DS);
  float* DEC = (float*)(ws + WS_DEC);
  float* GA = (float*)smem;
  float* PART = GA + 1024;
  u16* KT = (u16*)(PART + 512);
  u16* VT = KT + 256 * 72;
  const int tid = threadIdx.x, lane = tid & 63, w = tid >> 6, r = lane & 31, hh = lane >> 5;
  for (int it = blockIdx.x; it < 256; it += gridDim.x) {
    const int b = it >> 7, c = it & 127;
    const size_t tok0 = (size_t)b * SEQ + c * 64;
    for (int i = tid; i < 1024; i += NTHR) GA[i] = bf2f(PJ[(tok0 + (i >> 4)) * PP + C_GA + (i & 15)]);
    const int col = tid & 255, tg = tid >> 8;
    float au[16];
#pragma unroll
    for (int rr = 0; rr < 16; ++rr) au[rr] = p.a_up[rr * 256 + col];
    const float bias = p.a_bias[col];
    u16 kraw[32];
#pragma unroll
    for (int tt = 0; tt < 32; ++tt) kraw[tt] = PJ[(tok0 + tg * 32 + tt) * PP + C_GK + col];
    {
      const int vc = tid;
#pragma unroll
      for (int t8 = 0; t8 < 8; ++t8) {
        U8 o;
#pragma unroll
        for (int i = 0; i < 8; ++i) o.s[i] = PJ[(tok0 + t8 * 8 + i) * PP + C_GV + vc];
        *(uint4*)(VT + vc * 72 + t8 * 8) = o.u;
      }
    }
    __syncthreads();
    float pre[32];
    {
      float run = 0.f;
#pragma unroll
      for (int tt = 0; tt < 32; ++tt) {
        const int t = tg * 32 + tt;
        float u = bias;
#pragma unroll
        for (int rr = 0; rr < 16; ++rr) u += GA[t * 16 + rr] * au[rr];
        run += logsig(u) * (1.f / 16.f);
        pre[tt] = run;
      }
      PART[tg * 256 + col] = run;
    }
    __syncthreads();
    {
      const float p0 = PART[col], p1 = PART[256 + col];
      const float off = tg ? p0 : 0.f, blast = p0 + p1;
#pragma unroll
      for (int t8 = 0; t8 < 4; ++t8) {
        U8 o;
#pragma unroll
        for (int i = 0; i < 8; ++i) {
          const int tt = t8 * 8 + i;
          const float bv = off + pre[tt];
          BC[(tok0 + tg * 32 + tt) * 256 + col] = bv;
          o.s[i] = f2bf(bf2f(kraw[tt]) * __expf(blast - bv));
        }
        *(uint4*)(KT + col * 72 + tg * 32 + t8 * 8) = o.u;
      }
      if (tg == 0) DEC[((size_t)((b * 4 + (col >> 6)) * 128 + c)) * 64 + (col & 63)] = __expf(blast);
    }
    __syncthreads();
    {
      const int h = w >> 1, kt = w & 1;
      bf16x8 afr[4];
#pragma unroll
      for (int ts = 0; ts < 4; ++ts) {
        U8 a;
        a.u = *(const uint4*)(KT + (h * 64 + kt * 32 + r) * 72 + ts * 16 + hh * 8);
        afr[ts] = a.v;
      }
      const size_t item = (size_t)((b * 4 + h) * 128 + c);
#pragma unroll 1
      for (int vt = 0; vt < 4; ++vt) {
        f32x16 acc;
#pragma unroll
        for (int i = 0; i < 16; ++i) acc[i] = 0.f;
#pragma unroll
        for (int ts = 0; ts < 4; ++ts) {
          U8 bq;
          bq.u = *(const uint4*)(VT + (h * 128 + vt * 32 + r) * 72 + ts * 16 + hh * 8);
          acc = mfma32(afr[ts], bq.v, acc);
        }
#pragma unroll
        for (int i = 0; i < 16; ++i) {
          int kk = kt * 32 + (i & 3) + 8 * (i >> 2) + 4 * hh;
          DS[item * 8192 + kk * 128 + vt * 32 + r] = f2bf(acc[i]);
        }
      }
    }
    __syncthreads();
  }
}

__device__ __forceinline__ void phase3_scan(const Params& p) {
  unsigned char* ws = p.ws;
  u16* DS = (u16*)(ws + WS_DS);
  const float* DEC = (const float*)(ws + WS_DEC);
  const size_t gtid = (size_t)blockIdx.x * NTHR + threadIdx.x, gn = (size_t)gridDim.x * NTHR;
  for (size_t e = gtid; e < 65536; e += gn) {
    int bh = (int)(e >> 13), kv = (int)(e & 8191), k = kv >> 7;
    float S = 0.f;
    for (int c0 = 0; c0 < 128; c0 += 32) {
      float tmp[32], dc[32];
#pragma unroll
      for (int i = 0; i < 32; ++i) {
        tmp[i] = bf2f(DS[((size_t)(bh * 128 + c0 + i)) * 8192 + kv]);
        dc[i] = DEC[(size_t)(bh * 128 + c0 + i) * 64 + k];
      }
#pragma unroll
      for (int i = 0; i < 32; ++i) {
        DS[((size_t)(bh * 128 + c0 + i)) * 8192 + kv] = f2bf(S);
        S = dc[i] * S + tmp[i];
      }
    }
  }
}

__device__ __forceinline__ void phase4_gla3(const Params& p) {
  unsigned char* ws = p.ws;
  const u16* PJ = (const u16*)(ws + WS_PROJ);
  const float* BC = (const float*)(ws + WS_BCUM);
  const u16* DS = (const u16*)(ws + WS_DS);
  u16* MIX = (u16*)(ws + WS_XN);
  u16* QT = (u16*)smem;
  u16* KP = QT + 2 * 64 * 72;
  u16* ST = KP + 2 * 64 * 72;
  u16* VT = ST + 2 * 128 * 72;
  float* RED = (float*)(VT + 2 * 128 * 72);
  const int tid = threadIdx.x, lane = tid & 63, w = tid >> 6, r = lane & 31, hh = lane >> 5;
  for (int it = blockIdx.x; it < 512; it += gridDim.x) {
    const int b = it >> 8, c = (it >> 1) & 127, hp = it & 1;
    const size_t tok0 = (size_t)b * SEQ + c * 64;
    {
      const int colq = tid & 127, tg = tid >> 7;
      const int hd = colq >> 6, k = colq & 63, hcol = (hp * 2 + hd) * 64 + k;
      float bv[16];
      u16 qv[16], kv[16];
#pragma unroll
      for (int tt = 0; tt < 16; ++tt) {
        const size_t tok = tok0 + tg * 16 + tt;
        bv[tt] = BC[tok * 256 + hcol];
        qv[tt] = PJ[tok * PP + C_GQ + hcol];
        kv[tt] = PJ[tok * PP + C_GK + hcol];
      }
      const int vcol = tid & 255, half = tid >> 8;
      const int hd2 = vcol >> 7, v = vcol & 127;
      const size_t item = (size_t)((b * 4 + hp * 2 + hd2) * 128 + c);
      u16 sv[32];
      u16 vv[32];
#pragma unroll
      for (int i = 0; i < 32; ++i) {
        sv[i] = DS[item * 8192 + (half * 32 + i) * 128 + v];
        vv[i] = PJ[(tok0 + half * 32 + i) * PP + C_GV + (hp * 2 + hd2) * 128 + v];
      }
#pragma unroll
      for (int tt = 0; tt < 16; ++tt) {
        const int t = tg * 16 + tt;
        QT[(hd * 64 + t) * 72 + k] = f2bf(bf2f(qv[tt]) * 0.125f * __expf(bv[tt]));
        KP[(hd * 64 + t) * 72 + k] = f2bf(bf2f(kv[tt]) * __expf(-bv[tt]));
      }
#pragma unroll
      for (int q8 = 0; q8 < 4; ++q8) {
        U8 so, vo;
#pragma unroll
        for (int i = 0; i < 8; ++i) so.s[i] = sv[q8 * 8 + i];
#pragma unroll
        for (int i = 0; i < 8; ++i) vo.s[i] = vv[q8 * 8 + i];
        *(uint4*)(ST + (hd2 * 128 + v) * 72 + half * 32 + q8 * 8) = so.u;
        *(uint4*)(VT + (hd2 * 128 + v) * 72 + half * 32 + q8 * 8) = vo.u;
      }
    }
    __syncthreads();
    const int itile = w & 1, vt = w >> 1;
    uint2 zpre[2][4];
#pragma unroll
    for (int hd = 0; hd < 2; ++hd)
#pragma unroll
      for (int q4 = 0; q4 < 4; ++q4)
        zpre[hd][q4] = *(const uint2*)(PJ + (tok0 + itile * 32 + r) * PP + C_GZ + (hp * 2 + hd) * 128 + vt * 32 + 8 * q4 + 4 * hh);
    f32x16 o[2];
#pragma unroll
    for (int hd = 0; hd < 2; ++hd) {
      const u16* QTh = QT + hd * 64 * 72;
      const u16* KPh = KP + hd * 64 * 72;
      const u16* STh = ST + hd * 128 * 72;
      const u16* VTh = VT + hd * 128 * 72;
#pragma unroll
      for (int i = 0; i < 16; ++i) o[hd][i] = 0.f;
      bf16x8 qfr[4];
#pragma unroll
      for (int ks = 0; ks < 4; ++ks) {
        U8 q;
        q.u = *(const uint4*)(QTh + (itile * 32 + r) * 72 + ks * 16 + hh * 8);
        qfr[ks] = q.v;
        U8 a;
        a.u = *(const uint4*)(STh + (vt * 32 + r) * 72 + ks * 16 + hh * 8);
        o[hd] = mfma32(a.v, q.v, o[hd]);
      }
      for (int jt = 0; jt <= itile; ++jt) {
        f32x16 s;
#pragma unroll
        for (int i = 0; i < 16; ++i) s[i] = 0.f;
#pragma unroll
        for (int ks = 0; ks < 4; ++ks) {
          U8 a;
          a.u = *(const uint4*)(KPh + (jt * 32 + r) * 72 + ks * 16 + hh * 8);
          s = mfma32(a.v, qfr[ks], s);
        }
        const int ii = itile * 32 + r;
#pragma unroll
        for (int i = 0; i < 16; ++i) {
          int j = jt * 32 + (i & 3) + 8 * (i >> 2) + 4 * hh;
          if (j > ii) s[i] = 0.f;
        }
#pragma unroll
        for (int s2 = 0; s2 < 2; ++s2) {
          U8 pb, va;
          pb.u.x = pk2(s[8 * s2 + 0], s[8 * s2 + 1]);
          pb.u.y = pk2(s[8 * s2 + 2], s[8 * s2 + 3]);
          pb.u.z = pk2(s[8 * s2 + 4], s[8 * s2 + 5]);
          pb.u.w = pk2(s[8 * s2 + 6], s[8 * s2 + 7]);
          const u16* vp = VTh + (vt * 32 + r) * 72 + jt * 32 + s2 * 16 + hh * 4;
          va.h[0] = *(const uint2*)vp;
          va.h[1] = *(const uint2*)(vp + 8);
          o[hd] = mfma32(va.v, pb.v, o[hd]);
        }
      }
      float ss = 0.f;
#pragma unroll
      for (int i = 0; i < 16; ++i) ss += o[hd][i] * o[hd][i];
      ss += __shfl_xor(ss, 32);
      if (hh == 0) RED[(hd * 4 + vt) * 64 + itile * 32 + r] = ss;
    }
    __syncthreads();
#pragma unroll
    for (int hd = 0; hd < 2; ++hd) {
      const int h = hp * 2 + hd;
      const int ti = itile * 32 + r;
      const float* R4 = RED + hd * 256;
      float tot = R4[ti] + R4[64 + ti] + R4[128 + ti] + R4[192 + ti];
      float rstd = rsqrtf(tot * (1.f / 128.f) + EPSV);
      const size_t tok = tok0 + ti;
#pragma unroll
      for (int q4 = 0; q4 < 4; ++q4) {
        int v0 = vt * 32 + 8 * q4 + 4 * hh;
        uint2 zz = zpre[hd][q4];
        float4 gn = *(const float4*)(p.gnorm + v0);
        float z0 = bf2f((u16)(zz.x & 0xFFFF)), z1 = bf2f((u16)(zz.x >> 16)), z2 = bf2f((u16)(zz.y & 0xFFFF)),
              z3 = bf2f((u16)(zz.y >> 16));
        uint2 ov;
        ov.x = pk2(o[hd][4 * q4 + 0] * rstd * gn.x * siluf_(z0), o[hd][4 * q4 + 1] * rstd * gn.y * siluf_(z1));
        ov.y = pk2(o[hd][4 * q4 + 2] * rstd * gn.z * siluf_(z2), o[hd][4 * q4 + 3] * rstd * gn.w * siluf_(z3));
        *(uint2*)(MIX + tok * 1024 + h * 128 + v0) = ov;
      }
    }
    __syncthreads();
  }
}

constexpr int NSA_BUF = 18432;
constexpr int NSA_IMP_OFF = 2 * NSA_BUF;
constexpr int NSA_SEL_OFF = NSA_IMP_OFF + 64 * 128 * 4;
constexpr int NSA_OFIN_OFF = NSA_SEL_OFF + 1024;

__device__ __forceinline__ void tile_load(const u16* kp, int kpitch, const u16* vp, int vpitch, uint4& kr, uint4& vr) {
  int row = threadIdx.x >> 3, ch = threadIdx.x & 7;
  kr = *(const uint4*)(kp + (size_t)row * kpitch + ch * 8);
  vr = *(const uint4*)(vp + (size_t)row * vpitch + ch * 8);
}
__device__ __forceinline__ void tile_store(unsigned char* buf, uint4 kr, uint4 vr) {
  int row = threadIdx.x >> 3, ch = threadIdx.x & 7;
  *(uint4*)(buf + row * 144 + ch * 16) = kr;
  unsigned char* vb = buf + 9216 + row * 144 + (ch >> 1) * 32 + (ch & 1) * 8;
  *(uint2*)vb = make_uint2(vr.x, vr.y);
  *(uint2*)(vb + 16) = make_uint2(vr.z, vr.w);
}

template <int KIND, bool PRE = false>
__device__ __forceinline__ void nsa_segment(const u16* kp0, size_t kstride, int kpitch, const u16* vp0, size_t vstride,
                                            int vpitch, int nsteps, const bf16x8 (&qf)[4], f32x16 (&o)[2], float& mrun,
                                            float& lrun, int m_tile, int tl, int imax, unsigned long long sel_lo, unsigned long long sel_hi, float cm,
                                            float cinvl, int tokl, int g, int kb0, uint4 pre_k = uint4(), uint4 pre_v = uint4()) {
  const int lane = threadIdx.x & 63, r = lane & 31, hh = lane >> 5;
  float* imp = (float*)(smem + NSA_IMP_OFF);
  uint4 krA, vrA, krB, vrB;
  if (PRE) { krA = pre_k; vrA = pre_v; }
  else tile_load(kp0, kpitch, vp0, vpitch, krA, vrA);
  tile_store(smem, krA, vrA);
  {
    const int t1 = nsteps > 1 ? 1 : 0;
    tile_load(kp0 + (size_t)t1 * kstride, kpitch, vp0 + (size_t)t1 * vstride, vpitch, krA, vrA);
  }
  __syncthreads();
  auto body = [&](int s, uint4& k_issue, uint4& v_issue, uint4& k_store, uint4& v_store) {
    unsigned char* cur = smem + (s & 1) * NSA_BUF;
    unsigned char* nxt = smem + ((s + 1) & 1) * NSA_BUF;
    {
      const int tn = (s + 2 < nsteps) ? s + 2 : nsteps - 1;
      tile_load(kp0 + (size_t)tn * kstride, kpitch, vp0 + (size_t)tn * vstride, vpitch, k_issue, v_issue);
    }
    bool masked = false, rowvalid = true;
    int hi = 63, lo = -1;
    if (KIND <= 1) {
      masked = true;
      hi = imax - 64 * s;
      rowvalid = hi >= 0;
    } else if (KIND == 2) {
      if (s == m_tile) {
        masked = true;
        hi = tl;
      } else {
        unsigned long long sw = s < 64 ? sel_lo : sel_hi;
        rowvalid = (sw >> (s & 63)) & 1ull;
      }
    } else {
      int kb = kb0 + s;
      if (kb == m_tile - 8) {
        masked = true;
        lo = tl;
      } else if (kb == m_tile) {
        masked = true;
        hi = tl;
      }
    }
    if (s < nsteps && __ballot(rowvalid) != 0ull) {
      f32x16 sc[2];
      U8 kf[8];
#pragma unroll
      for (int kt = 0; kt < 2; ++kt)
#pragma unroll
        for (int ds = 0; ds < 4; ++ds) kf[kt * 4 + ds].u = *(const uint4*)(cur + (kt * 32 + r) * 144 + ds * 32 + hh * 16);
      __builtin_amdgcn_sched_barrier(0);
#pragma unroll
      for (int kt = 0; kt < 2; ++kt) {
#pragma unroll
        for (int i = 0; i < 16; ++i) sc[kt][i] = 0.f;
#pragma unroll
        for (int ds = 0; ds < 4; ++ds) sc[kt] = mfma32(kf[kt * 4 + ds].v, qf[ds], sc[kt]);
      }
      U8 vf[8];
      if (KIND >= 1) {
#pragma unroll
        for (int kt = 0; kt < 2; ++kt)
#pragma unroll
          for (int s2 = 0; s2 < 2; ++s2)
#pragma unroll
            for (int dt = 0; dt < 2; ++dt) {
              vf[(kt * 2 + s2) * 2 + dt].u = *(const uint4*)(cur + 9216 + (dt * 32 + r) * 144 + (kt * 2 + s2) * 32 + hh * 16);
            }
      }
      __builtin_amdgcn_sched_barrier(0);
      const float NEG_INF = -__builtin_inff();
      if (KIND == 1) {
#pragma unroll
        for (int kt = 0; kt < 2; ++kt)
#pragma unroll
          for (int i = 0; i < 16; ++i) {
            int kl = kt * 32 + (i & 3) + 8 * (i >> 2) + 4 * hh;
            float pv = ex2(sc[kt][i] * QSCALE_L2 - cm) * cinvl;
            sc[kt][i] = (kl <= hi) ? pv : 0.f;
          }
#pragma unroll
        for (int kt = 0; kt < 2; ++kt)
#pragma unroll
          for (int q4 = 0; q4 < 4; ++q4) {
            float s4 = sc[kt][4 * q4] + sc[kt][4 * q4 + 1] + sc[kt][4 * q4 + 2] + sc[kt][4 * q4 + 3];
            float sp = sc[kt][4 * q4 + 3];
            s4 = quad_sum(s4);
            sp = quad_sum(sp);
            if (g == 0) {
              int jb = (64 * s + kt * 32 + 8 * q4 + 4 * hh) >> 2;
              atomicAdd(&imp[tokl * 128 + jb], s4);
              if (jb + 1 < 128) atomicAdd(&imp[tokl * 128 + jb + 1], sp);
            }
          }
      } else {
        float mx = NEG_INF;
        if (masked) {
#pragma unroll
          for (int kt = 0; kt < 2; ++kt)
#pragma unroll
            for (int i = 0; i < 16; ++i) {
              int kl = kt * 32 + (i & 3) + 8 * (i >> 2) + 4 * hh;
              bool ok = (kl <= hi) && (kl > lo);
              sc[kt][i] = ok ? sc[kt][i] : NEG_INF;
              mx = fmaxf(mx, sc[kt][i]);
            }
        } else {
#pragma unroll
          for (int kt = 0; kt < 2; ++kt)
#pragma unroll
            for (int i = 0; i < 16; ++i) mx = fmaxf(mx, sc[kt][i]);
          if (!rowvalid) mx = NEG_INF;
        }
        {
          const unsigned mu = __float_as_uint(mx);
          auto sw = __builtin_amdgcn_permlane32_swap(mu, mu, false, false);
          mx = fmaxf(__uint_as_float(sw[0]), __uint_as_float(sw[1]));
        }
        const float mxc = mx * QSCALE_L2;
        const bool need = mxc > mrun + 8.f;
        if (__ballot(need) != 0ull) {
          float mnew = need ? mxc : mrun;
          float alpha = ex2(mrun - mnew);
          lrun *= alpha;
          mrun = mnew;
          if (KIND >= 2) {
#pragma unroll
            for (int dt = 0; dt < 2; ++dt)
#pragma unroll
              for (int i = 0; i < 16; ++i) o[dt][i] *= alpha;
          }
        }
        float moff = (masked || rowvalid) ? mrun : __builtin_inff();
        float psum = 0.f;
#pragma unroll
        for (int kt = 0; kt < 2; ++kt)
#pragma unroll
          for (int i = 0; i < 16; ++i) {
            float pv = ex2(sc[kt][i] * QSCALE_L2 - moff);
            sc[kt][i] = pv;
            psum += pv;
          }
        lrun += psum;
      }
      if (KIND >= 1) {
#pragma unroll
        for (int kt = 0; kt < 2; ++kt)
#pragma unroll
          for (int s2 = 0; s2 < 2; ++s2) {
            U8 pb;
            pb.u.x = pk2(sc[kt][8 * s2 + 0], sc[kt][8 * s2 + 1]);
            pb.u.y = pk2(sc[kt][8 * s2 + 2], sc[kt][8 * s2 + 3]);
            pb.u.z = pk2(sc[kt][8 * s2 + 4], sc[kt][8 * s2 + 5]);
            pb.u.w = pk2(sc[kt][8 * s2 + 6], sc[kt][8 * s2 + 7]);
#pragma unroll
            for (int dt = 0; dt < 2; ++dt) o[dt] = mfma32(vf[(kt * 2 + s2) * 2 + dt].v, pb.v, o[dt]);
          }
      }
    }
    tile_store(nxt, k_store, v_store);
    __syncthreads();
  };
  const int nst2 = (nsteps + 1) & ~1;
  for (int s = 0; s < nst2; s += 2) {
    body(s, krB, vrB, krA, vrA);
    body(s + 1, krA, vrA, krB, vrB);
  }
}

__device__ __forceinline__ void nsa_item(const Params& p, int b, int kvh, int m) {
  unsigned char* ws = p.ws;
  const u16* PJ = (const u16*)(ws + WS_PROJ);
  u16* MIX = (u16*)(ws + WS_XN);
  int tid = threadIdx.x;
  asm volatile("" : "+v"(tid));
  const int lane = tid & 63, w = tid >> 6, r = lane & 31, hh = lane >> 5;
  const int tokl = 8 * w + (r >> 2), g = r & 3, head = kvh * 4 + g;
  const int q0 = m * 64, t = q0 + tokl;
  const size_t tokg = (size_t)b * SEQ + t;
  float* imp = (float*)(smem + NSA_IMP_OFF);
  unsigned* selw = (unsigned*)(smem + NSA_SEL_OFF);
  for (int i = tid; i < 64 * 128; i += NTHR) imp[i] = 0.f;
  bf16x8 qf[4];
#pragma unroll
  for (int ds = 0; ds < 4; ++ds) {
    U8 q;
    q.u = *(const uint4*)(PJ + tokg * PP + C_NQ + head * 64 + ds * 16 + hh * 8);
    qf[ds] = q.v;
  }
  float gate[3];
#pragma unroll
  for (int br = 0; br < 3; ++br) gate[br] = sigmoidf_(bf2f(PJ[tokg * PP + C_NG + head * 3 + br]));
  f32x16 o[2];
  float* ofl = (float*)(smem + NSA_OFIN_OFF) + tid;
#pragma unroll
  for (int dt = 0; dt < 2; ++dt)
#pragma unroll
    for (int i = 0; i < 16; ++i) o[dt][i] = 0.f;
  unsigned long long sel_lo = 0ull, sel_hi = 0ull;
  const int imax = (t - 31) >> 4;
  {
    const int nct = ((4 * m + 2) >> 6) + 1;
    const u16* kc = (const u16*)(ws + WS_KC) + (size_t)(b * 2 + kvh) * 512 * 64;
    const u16* vct = (const u16*)(ws + WS_VCT) + (size_t)(b * 2 + kvh) * 64 * 512;
    float mrun = -1e30f, lrun = 0.f;
    nsa_segment<0>(kc, 64 * 64, 64, vct, 64, 512, nct, qf, o, mrun, lrun, m, tokl, imax, sel_lo, sel_hi, 0.f, 0.f, tokl, g, 0);
    float ltot = lrun + __shfl_xor(lrun, 32);
    float cinvl = ltot > 0.f ? 1.f / ltot : 0.f;
    float dm = 0.f, dl = 0.f;
    nsa_segment<1>(kc, 64 * 64, 64, vct, 64, 512, nct, qf, o, dm, dl, m, tokl, imax, sel_lo, sel_hi, mrun, cinvl, tokl, g, 0);
#pragma unroll
    for (int dt = 0; dt < 2; ++dt)
#pragma unroll
      for (int i = 0; i < 16; ++i) { ofl[(dt * 16 + i) * NTHR] = o[dt][i] * gate[0]; o[dt][i] = 0.f; }
  }
  uint4 slc_k0, slc_v0;
  tile_load(PJ + (size_t)b * SEQ * PP + C_KS + kvh * 64, PP, (const u16*)(ws + WS_VST) + (size_t)(b * 2 + kvh) * 64 * SEQ, SEQ, slc_k0, slc_v0);
  __syncthreads();
  if (m < 16) {
    sel_lo = (1ull << (m + 1)) - 1ull;
  } else {
    {
      const int tk = lane >> 3, sub = lane & 7;
      const int tl2 = 8 * w + tk;
      unsigned key[16];
#pragma unroll
      for (int i = 0; i < 16; ++i) {
        const int j = sub + 8 * i;
        unsigned kv = (__float_as_uint(imp[tl2 * 128 + j]) & 0xFFFFFF80u) | (unsigned)(127 - j);
        key[i] = (j >= 1 && j <= m - 2) ? kv : 0u;
      }
      unsigned tau = 0u;
      for (int bit = 30; bit >= 0; --bit) {
        const unsigned cand = tau | (1u << bit);
        int cnt = 0;
#pragma unroll
        for (int i = 0; i < 16; ++i) cnt += (key[i] >= cand) ? 1 : 0;
        cnt += __builtin_amdgcn_mov_dpp(cnt, 0xB1, 0xF, 0xF, true);
        cnt += __builtin_amdgcn_mov_dpp(cnt, 0x4E, 0xF, 0xF, true);
        cnt += __builtin_amdgcn_mov_dpp(cnt, 0x141, 0xF, 0xF, true);
        if (cnt >= 13) tau = cand;
      }
      unsigned wsel[4] = {0u, 0u, 0u, 0u};
#pragma unroll
      for (int i = 0; i < 16; ++i)
        if (key[i] >= tau && key[i] != 0u) wsel[i >> 2] |= 1u << (8 * (i & 3) + sub);
#pragma unroll
      for (int q = 0; q < 4; ++q) {
        unsigned v = wsel[q];
        v |= (unsigned)__builtin_amdgcn_mov_dpp((int)v, 0xB1, 0xF, 0xF, true);
        v |= (unsigned)__builtin_amdgcn_mov_dpp((int)v, 0x4E, 0xF, 0xF, true);
        v |= (unsigned)__builtin_amdgcn_mov_dpp((int)v, 0x141, 0xF, 0xF, true);
        wsel[q] = v;
      }
      wsel[0] |= 1u;
      {
        const int f1 = m, f2 = m - 1;
#pragma unroll
        for (int q = 0; q < 4; ++q) {
          if ((f1 >> 5) == q) wsel[q] |= 1u << (f1 & 31);
          if ((f2 >> 5) == q) wsel[q] |= 1u << (f2 & 31);
        }
      }
      if (sub == 0) {
        selw[tl2 * 4 + 0] = wsel[0];
        selw[tl2 * 4 + 1] = wsel[1];
        selw[tl2 * 4 + 2] = wsel[2];
        selw[tl2 * 4 + 3] = wsel[3];
      }
    }
    __syncthreads();
    sel_lo = (unsigned long long)selw[tokl * 4 + 0] | ((unsigned long long)selw[tokl * 4 + 1] << 32);
    sel_hi = (unsigned long long)selw[tokl * 4 + 2] | ((unsigned long long)selw[tokl * 4 + 3] << 32);
  }
  {
    const u16* kp = PJ + (size_t)b * SEQ * PP + C_KS + kvh * 64;
    const u16* vp = (const u16*)(ws + WS_VST) + (size_t)(b * 2 + kvh) * 64 * SEQ;
    float mrun = -1e30f, lrun = 0.f;
    nsa_segment<2, true>(kp, (size_t)64 * PP, PP, vp, 64, SEQ, m + 1, qf, o, mrun, lrun, m, tokl, imax, sel_lo, sel_hi, 0.f, 0.f, tokl, g, 0, slc_k0, slc_v0);
    float ltot = lrun + __shfl_xor(lrun, 32);
    float sc = gate[1] / ltot;
#pragma unroll
    for (int dt = 0; dt < 2; ++dt)
#pragma unroll
      for (int i = 0; i < 16; ++i) { ofl[(dt * 16 + i) * NTHR] += o[dt][i] * sc; o[dt][i] = 0.f; }
  }
  {
    const int kb0 = m >= 8 ? m - 8 : 0;
    const u16* kp = PJ + ((size_t)b * SEQ + (size_t)kb0 * 64) * PP + C_KW + kvh * 64;
    const u16* vp = (const u16*)(ws + WS_VWT) + (size_t)(b * 2 + kvh) * 64 * SEQ + (size_t)kb0 * 64;
    float mrun = -1e30f, lrun = 0.f;
    nsa_segment<3>(kp, (size_t)64 * PP, PP, vp, 64, SEQ, m - kb0 + 1, qf, o, mrun, lrun, m, tokl, imax, sel_lo, sel_hi, 0.f, 0.f, tokl, g, kb0);
    float ltot = lrun + __shfl_xor(lrun, 32);
    float sc = gate[2] / ltot;
#pragma unroll
    for (int dt = 0; dt < 2; ++dt)
#pragma unroll
      for (int i = 0; i < 16; ++i) o[dt][i] = ofl[(dt * 16 + i) * NTHR] + o[dt][i] * sc;
  }
#pragma unroll
  for (int dt = 0; dt < 2; ++dt)
#pragma unroll
    for (int q4 = 0; q4 < 4; ++q4) {
      int d0 = dt * 32 + 8 * q4 + 4 * hh;
      uint2 zz = *(const uint2*)(PJ + tokg * PP + C_NZ + head * 64 + d0);
      float z0 = bf2f((u16)(zz.x & 0xFFFF)), z1 = bf2f((u16)(zz.x >> 16)), z2 = bf2f((u16)(zz.y & 0xFFFF)),
            z3 = bf2f((u16)(zz.y >> 16));
      uint2 ov;
      ov.x = pk2(o[dt][4 * q4 + 0] * siluf_(z0), o[dt][4 * q4 + 1] * siluf_(z1));
      ov.y = pk2(o[dt][4 * q4 + 2] * siluf_(z2), o[dt][4 * q4 + 3] * siluf_(z3));
      *(uint2*)(MIX + tokg * 1024 + 512 + head * 64 + d0) = ov;
    }
  __syncthreads();
}

__device__ __forceinline__ void phase4_nsa(const Params& p) {
  for (int wk = blockIdx.x; wk < 256; wk += gridDim.x) {
    int bk = wk >> 6, i = wk & 63;
#pragma unroll 1
    for (int rep = 0; rep < 2; ++rep) nsa_item(p, bk >> 1, bk & 1, rep ? i : 127 - i);
  }
}

__device__ __forceinline__ void phase6_res(const Params& p) {
  unsigned char* ws = p.ws;
  const uint2* MX = (const uint2*)(ws + WS_PROJ);
  const float* SS = (const float*)(ws + WS_SS1);
  u16* HB = (u16*)(ws + WS_XN);
  const size_t gtid = (size_t)blockIdx.x * NTHR + threadIdx.x, gn = (size_t)gridDim.x * NTHR;
  for (size_t i = gtid; i < (size_t)MTOK * 256; i += gn) {
    int row = (int)(i >> 8), c4 = (int)(i & 255);
    float rstd = rsqrtf(SS[row] * (1.f / 1024.f) + EPSV);
    uint2 mb = MX[i];
    float4 xv = ((const float4*)p.x)[i], gv = ((const float4*)p.post_norm)[c4];
    float4 hv;
    hv.x = xv.x + bf2f((u16)(mb.x & 0xFFFF)) * rstd * gv.x;
    hv.y = xv.y + bf2f((u16)(mb.x >> 16)) * rstd * gv.y;
    hv.z = xv.z + bf2f((u16)(mb.y & 0xFFFF)) * rstd * gv.z;
    hv.w = xv.w + bf2f((u16)(mb.y >> 16)) * rstd * gv.w;
    uint2 o;
    o.x = pk2(hv.x, hv.y);
    o.y = pk2(hv.z, hv.w);
    *(uint2*)(HB + i * 4) = o;
  }
}
__device__ __forceinline__ void phase8_out(const Params& p) {
  unsigned char* ws = p.ws;
  const uint2* HB = (const uint2*)(ws + WS_XN);
  const uint2* E = (const uint2*)(ws + WS_PROJ + (size_t)MTOK * 1024 * 2);
  const float* SS2 = (const float*)(ws + WS_SS2);
  const size_t gtid = (size_t)blockIdx.x * NTHR + threadIdx.x, gn = (size_t)gridDim.x * NTHR;
  for (size_t i = gtid; i < (size_t)MTOK * 256; i += gn) {
    int row = (int)(i >> 8), c4 = (int)(i & 255);
    float r2 = rsqrtf(SS2[row] * (1.f / 1024.f) + EPSV);
    uint2 hb = HB[i], eb = E[i];
    float4 g2 = ((const float4*)p.ple_norm)[c4];
    float4 hv;
    hv.x = bf2f((u16)(hb.x & 0xFFFF)) + bf2f((u16)(eb.x & 0xFFFF)) * r2 * g2.x;
    hv.y = bf2f((u16)(hb.x >> 16)) + bf2f((u16)(eb.x >> 16)) * r2 * g2.y;
    hv.z = bf2f((u16)(hb.y & 0xFFFF)) + bf2f((u16)(eb.y & 0xFFFF)) * r2 * g2.z;
    hv.w = bf2f((u16)(hb.y >> 16)) + bf2f((u16)(eb.y >> 16)) * r2 * g2.w;
    ((float4*)p.out)[i] = hv;
  }
}

#define XB_TMO 128
#define XB_XCNT(j) (256 + 64 * (j))
#define XB_XSUB(j) (1280 + 64 * (j))
#define XB_XGEN(j) (2304 + 64 * (j))
#define XB_TOP 3328
#define XB_TOPGEN 3392
#define XCD_BAR_WORDS 3456
#define XB_SPIN_CAP (1u << 18)
#define LAS __attribute__((address_space(3)))
__device__ __forceinline__ unsigned xb_ld(unsigned* p) { return __hip_atomic_load(p, __ATOMIC_RELAXED, __HIP_MEMORY_SCOPE_AGENT); }
__device__ __forceinline__ unsigned xb_add(unsigned* p, unsigned v) { return __hip_atomic_fetch_add(p, v, __ATOMIC_RELAXED, __HIP_MEMORY_SCOPE_AGENT); }
__device__ __forceinline__ unsigned xb_xcc_id() { return (unsigned)__builtin_amdgcn_s_getreg((3 << 11) | 20) & 0xFu; }
#define XB_SPIN(cond, bar)                                            \
  do {                                                                \
    unsigned _sp = 0;                                                 \
    while (cond) {                                                    \
      __builtin_amdgcn_s_sleep(1);                                    \
      if ((++_sp & 255u) == 0u) {                                     \
        if (xb_ld(&(bar)[XB_TMO])) break;                             \
        if (_sp > XB_SPIN_CAP) { atomicAdd(&(bar)[XB_TMO], 1u); break; } \
      }                                                               \
    }                                                                 \
  } while (0)
struct XcdBarrier {
  unsigned* bar;
  unsigned x;
  volatile LAS unsigned* st;
};
__device__ __forceinline__ XcdBarrier xcd_barrier_post(unsigned* bar, volatile LAS unsigned* st) {
  XcdBarrier b;
  b.bar = bar;
  b.x = xb_xcc_id();
  b.st = st;
  if (threadIdx.x == 0) (void)xb_add(&bar[XB_XCNT(b.x)], 1u);
  return b;
}
__device__ __forceinline__ void xcd_barrier_complete(unsigned* bar, unsigned x, unsigned& nloc, unsigned& nx) {
  const unsigned G = gridDim.x * gridDim.y * gridDim.z;
  unsigned sum, cnt, mine, sp = 0u;
  for (;;) {
    sum = 0u; cnt = 0u; mine = 0u;
#pragma unroll
    for (unsigned j = 0; j < 16; ++j) {
      const unsigned c = xb_ld(&bar[XB_XCNT(j)]);
      sum += c;
      cnt += (c > 0u) ? 1u : 0u;
      mine = (j == x) ? c : mine;
    }
    if (sum == G) break;
    __builtin_amdgcn_s_sleep(1);
    if ((++sp & 255u) == 0u) {
      if (xb_ld(&bar[XB_TMO])) break;
      if (sp > XB_SPIN_CAP) { atomicAdd(&bar[XB_TMO], 1u); break; }
    }
  }
  nloc = mine > 0u ? mine : 1u;
  nx = cnt > 0u ? cnt : 1u;
}
__device__ __forceinline__ void xcd_barrier(const XcdBarrier& b) {
  asm volatile("s_waitcnt vmcnt(0)" ::: "memory");
  __syncthreads();
  if (threadIdx.x == 0) {
    unsigned* bar = b.bar;
    __builtin_amdgcn_s_waitcnt(0);
    unsigned nloc = b.st[0], nx = b.st[1];
    if (nloc == 0u) {
      xcd_barrier_complete(bar, b.x, nloc, nx);
      b.st[0] = nloc;
      b.st[1] = nx;
    }
    const unsigned old = xb_add(&bar[XB_XSUB(b.x)], 1u);
    const unsigned gen = old / nloc;
    if (old + 1u == (gen + 1u) * nloc) {
      __builtin_amdgcn_fence(__ATOMIC_RELEASE, "agent");
      asm volatile("s_waitcnt vmcnt(0)" ::: "memory");
      const unsigned og = xb_add(&bar[XB_TOP], 1u);
      const unsigned tg = og / nx;
      if (og + 1u == (tg + 1u) * nx) xb_add(&bar[XB_TOPGEN], 1u);
      else XB_SPIN(xb_ld(&bar[XB_TOPGEN]) == tg, bar);
      __builtin_amdgcn_fence(__ATOMIC_ACQUIRE, "agent");
      xb_add(&bar[XB_XGEN(b.x)], 1u);
      asm volatile("s_waitcnt vmcnt(0)" ::: "memory");
    } else {
      XB_SPIN(xb_ld(&bar[XB_XGEN(b.x)]) == gen, bar);
      __builtin_amdgcn_fence(__ATOMIC_ACQUIRE, "agent");
      asm volatile("s_waitcnt vmcnt(0)" ::: "memory");
    }
  }
  __syncthreads();
}

#define NPHASE 9
#if !FUSED
__device__ __forceinline__ void run_phase(const Params& p, int ph) {
#ifdef ONLY_PHASE
  ph = ONLY_PHASE;
#endif
  switch (ph) {
    case 0: phase_prep(p); break;
    case 1: gemm_phase<0>(p); break;
    case 2: phase2_rope(p); phase2_vtrans(p); phase2_compress(p); phase2_gla1(p); break;
    case 3: phase3_scan(p); break;
    case 4: phase4_nsa(p); phase4_gla3(p); break;
    case 5: gemm_phase<1>(p); break;
    case 6: phase6_res(p); break;
    case 7: gemm_phase<2>(p); break;
    default: phase8_out(p); break;
  }
}
#endif

#ifndef DUP
#define DUP -1
#endif
constexpr int LDS_BYTES = 139264;
constexpr int LDS_BAR_OFF = LDS_BYTES - 16;
#define GSYNC() xcd_barrier(xb)
__global__ void __launch_bounds__(NTHR) mega_kernel(Params p) {
  cg::grid_group grid = cg::this_grid();
  volatile LAS unsigned* st = (volatile LAS unsigned*)(smem + LDS_BAR_OFF);
  if (threadIdx.x == 0) { st[0] = 0u; st[1] = 0u; }
  __syncthreads();
  XcdBarrier xb = xcd_barrier_post((unsigned*)(p.ws + WS_BAR), st);
  phase_prep(p);
  if (gridDim.x == 0x7FFFFFFFu) grid.sync();
  GSYNC();
  if (DUP == 0) { phase_prep(p); GSYNC(); }
  gemm_phase<0>(p);
  GSYNC();
  if (DUP == 1) { gemm_phase<0>(p); GSYNC(); }
  if (DUP == 20) { phase2_vtrans(p); GSYNC(); }
  if (DUP == 21) { phase2_compress(p); GSYNC(); }
  if (DUP == 22) { phase2_gla1(p); GSYNC(); }
  phase2_rope(p);
  phase2_vtrans(p);
#pragma unroll 1
  for (int st = 0; st < 2; ++st) {
    if ((st ^ (int)(blockIdx.x & 1)) == 0) phase2_compress(p);
    else phase2_gla1(p);
  }
  GSYNC();
  phase3_scan(p);
  GSYNC();
  if (DUP == 40) { phase4_nsa(p); GSYNC(); }
  if (DUP == 41) { phase4_gla3(p); GSYNC(); }
#pragma unroll 1
  for (int st = 0; st < 2; ++st) {
    if ((st ^ (int)(blockIdx.x & 1)) == 0) phase4_nsa(p);
    else phase4_gla3(p);
  }
  GSYNC();
  gemm_phase<1>(p);
  GSYNC();
  if (DUP == 6) { phase6_res(p); GSYNC(); }
  gemm_phase<2>(p);
  return;
  GSYNC();
  if (DUP == 99) { for (int i = 0; i < 8; ++i) GSYNC(); }
  if (DUP == 8) { phase8_out(p); GSYNC(); }
  phase8_out(p);
}
#if !FUSED
__global__ void __launch_bounds__(NTHR) phase_kernel(Params p, int ph) { run_phase(p, ph); }
#endif


extern "C" void kernel_launch(void* const* d_in, const int* in_sizes, int n_in, void* d_out, int out_size, void* d_ws,
                              size_t ws_size, hipStream_t stream) {
  static int grid_blocks = 0;
  if (!grid_blocks) {
    int dev = 0, cus = 0, per_cu = 0;
    hipGetDevice(&dev);
    hipDeviceGetAttribute(&cus, hipDeviceAttributeMultiprocessorCount, dev);
    hipFuncSetAttribute((const void*)mega_kernel, hipFuncAttributeMaxDynamicSharedMemorySize, LDS_BYTES);
#if !FUSED
    hipFuncSetAttribute((const void*)phase_kernel, hipFuncAttributeMaxDynamicSharedMemorySize, LDS_BYTES);
#endif
    hipOccupancyMaxActiveBlocksPerMultiprocessor(&per_cu, (const void*)mega_kernel, NTHR, LDS_BYTES);
    if (per_cu < 1) {
      fprintf(stderr, "occupancy query returned %d\n", per_cu);
      per_cu = 1;
    }
    if (per_cu > 1) per_cu = 1;
    grid_blocks = cus * per_cu;
    if (ws_size < WS_END2) fprintf(stderr, "workspace too small: %zu < %zu\n", ws_size, (size_t)WS_END2);
  }
  Params p{};
  p.x = (const float*)d_in[0];
  p.p = (const float*)d_in[1];
  p.pre_norm = (const float*)d_in[2];
  p.w_in = (const float*)d_in[3];
  p.a_up = (const float*)d_in[4];
  p.a_bias = (const float*)d_in[5];
  p.gnorm = (const float*)d_in[6];
  p.pos_k = (const float*)d_in[7];
  p.w1k = (const float*)d_in[8];
  p.w2k = (const float*)d_in[9];
  p.pos_v = (const float*)d_in[10];
  p.w1v = (const float*)d_in[11];
  p.w2v = (const float*)d_in[12];
  p.w_out = (const float*)d_in[13];
  p.post_norm = (const float*)d_in[14];
  p.ple_proj = (const float*)d_in[15];
  p.ple_gate = (const float*)d_in[16];
  p.ple_norm = (const float*)d_in[17];
  p.out = (float*)d_out;
  p.ws = (unsigned char*)d_ws;
#if FUSED
  hipMemsetAsync((char*)d_ws + WS_BAR, 0, 16384, stream);
  void* args[] = {&p};
  hipError_t e = hipLaunchCooperativeKernel((const void*)mega_kernel, dim3(grid_blocks), dim3(NTHR), args, LDS_BYTES, stream);
  if (e != hipSuccess) fprintf(stderr, "cooperative launch failed: %s (grid %d)\n", hipGetErrorString(e), grid_blocks);
#else
  for (int ph = 0; ph < NPHASE; ++ph) hipLaunchKernelGGL(phase_kernel, dim3(grid_blocks), dim3(NTHR), LDS_BYTES, stream, p, ph);
#endif
}
```
